# Optimizing an MI355X kernel written in HIP

```python
import jax, jax.numpy as jnp
from jax import lax
import numpy as np

D_MODEL = 1024
BATCH = 4
SEQ = 4096
DEPTH = 1

HG_WIDTH = D_MODEL // 2
HG_HEAD_DIM = 128
HG_HEADS = HG_WIDTH // HG_HEAD_DIM
ML_WIDTH = D_MODEL - HG_WIDTH
ML_V_DIM = 128
ML_HEADS = ML_WIDTH // ML_V_DIM
ML_QK_DIM = ML_V_DIM // 2
D_MIX = HG_WIDTH + ML_WIDTH
CONV_WIDTH = 4
D_FF = 2816
CHUNK = 64
EPS = 1e-6
SPLIT_SIZES = (HG_WIDTH, HG_WIDTH, HG_WIDTH, HG_WIDTH,
               ML_HEADS * ML_QK_DIM, ML_HEADS * ML_QK_DIM,
               ML_WIDTH, ML_WIDTH,
               ML_HEADS, ML_HEADS)
D_IN = 4 * HG_WIDTH + 2 * ML_HEADS * ML_QK_DIM + 2 * ML_WIDTH + 2 * ML_HEADS

kernel_name = "hymba_hgrn2_mlstm_macaron_sandwich"


def rms_norm(x, g):
    xf = x.astype(jnp.float32)
    y = xf * lax.rsqrt(jnp.mean(xf * xf, axis=-1, keepdims=True) + EPS)
    return (y * g.astype(jnp.float32)).astype(x.dtype)


def swiglu_ffn(x, w_in, w_out):
    gate, up = jnp.split(x @ w_in, 2, axis=-1)
    return (jax.nn.silu(gate) * up) @ w_out


def split_cols(x, sizes):
    outs, start = [], 0
    for s in sizes:
        outs.append(x[..., start:start + s])
        start += s
    return outs


def causal_depthwise_conv(x, w, b):
    y = lax.conv_general_dilated(
        x, w[:, None, :].astype(x.dtype), window_strides=(1,),
        padding=[(CONV_WIDTH - 1, 0)], dimension_numbers=("NWC", "WIO", "NWC"),
        feature_group_count=x.shape[-1])
    return y + b.astype(x.dtype)


def to_chunks(x):
    B, T, H, d = x.shape
    return x.reshape(B, T // CHUNK, CHUNK, H, d).transpose(1, 0, 3, 2, 4)


def scalar_to_chunks(x):
    B, T, H = x.shape
    return x.reshape(B, T // CHUNK, CHUNK, H).transpose(1, 0, 3, 2)


def from_chunks(y):
    NC, B, H, L, d = y.shape
    return y.transpose(1, 0, 3, 2, 4).reshape(B, NC * L, H, d)


def hgrn2_chunkwise(q, k, v, log_f):
    B, T, H, dk = q.shape
    dv = v.shape[-1]
    causal = jnp.tril(jnp.ones((CHUNK, CHUNK), dtype=bool))[:, :, None]

    def step(S, inp):
        qc, kc, vc, gc = inp
        G = jnp.cumsum(gc, axis=2)
        o_inter = jnp.einsum("bhtk,bhkv->bhtv", qc * jnp.exp(G), S)
        rel = G[:, :, :, None, :] - G[:, :, None, :, :]
        decay = jnp.exp(jnp.where(causal, rel, -jnp.inf))
        scores = jnp.sum(qc[:, :, :, None, :] * kc[:, :, None, :, :] * decay, axis=-1)
        o = o_inter + jnp.einsum("bhts,bhsv->bhtv", scores, vc)
        G_end = G[:, :, -1:, :]
        S_new = jnp.exp(G_end[:, :, 0, :])[..., None] * S + jnp.einsum(
            "bhsk,bhsv->bhkv", kc * jnp.exp(G_end - G), vc)
        return S_new, o

    S0 = jnp.zeros((B, H, dk, dv), jnp.float32)
    _, o = lax.scan(step, S0, (to_chunks(q), to_chunks(k), to_chunks(v), to_chunks(log_f)))
    return from_chunks(o)


def mlstm_chunkwise(q, k, v, log_i, log_f):
    B, T, H, dqk = q.shape
    dv = v.shape[-1]
    causal = jnp.tril(jnp.ones((CHUNK, CHUNK), dtype=bool))

    def step(carry, inp):
        C, n, m = carry
        qc, kc, vc, ic, fc = inp
        b = jnp.cumsum(fc, axis=-1)
        a = b + m[..., None]
        D = jnp.where(causal, b[..., :, None] - b[..., None, :] + ic[..., None, :], -jnp.inf)
        m_t = jnp.maximum(a, jnp.max(D, axis=-1))
        inter = jnp.exp(a - m_t)
        P = jnp.einsum("bhtd,bhsd->bhts", qc, kc) * jnp.exp(D - m_t[..., None])
        num = inter[..., None] * jnp.einsum("bhtd,bhdv->bhtv", qc, C) + jnp.einsum("bhts,bhsv->bhtv", P, vc)
        den = inter * jnp.einsum("bhtd,bhd->bht", qc, n) + jnp.sum(P, axis=-1)
        h = num / jnp.maximum(jnp.abs(den), jnp.exp(-m_t))[..., None]
        m_new = m_t[..., -1]
        w = jnp.exp(b[..., -1:] - b + ic - m_new[..., None])
        keep = inter[..., -1]
        C_new = keep[..., None, None] * C + jnp.einsum("bhs,bhsd,bhsv->bhdv", w, kc, vc)
        n_new = keep[..., None] * n + jnp.einsum("bhs,bhsd->bhd", w, kc)
        return (C_new, n_new, m_new), h

    init = (jnp.zeros((B, H, dqk, dv), jnp.float32), jnp.zeros((B, H, dqk), jnp.float32),
            jnp.zeros((B, H), jnp.float32))
    _, h = lax.scan(step, init, (to_chunks(q), to_chunks(k), to_chunks(v),
                                 scalar_to_chunks(log_i), scalar_to_chunks(log_f)))
    return from_chunks(h)


def token_mixer(h, w_in, conv_w, conv_b, gate_bias, lb, hg_norm, ml_norm, w_out):
    B, T, _ = h.shape
    f32 = jnp.float32
    hq, hf, hi, hgate, mq, mk, mv, mo, mig, mfg = split_cols(h @ w_in, SPLIT_SIZES)
    hs = (B, T, HG_HEADS, HG_HEAD_DIM)
    lbh = lb.reshape(HG_HEADS, HG_HEAD_DIM)
    forget = lbh + (1.0 - lbh) * jax.nn.sigmoid(hf.astype(f32).reshape(hs))
    hg_o = hgrn2_chunkwise(jax.nn.silu(hq.astype(f32)).reshape(hs), 1.0 - forget,
                           hi.astype(f32).reshape(hs), jnp.log(forget))
    hg_o = rms_norm(hg_o, hg_norm.reshape(HG_HEADS, HG_HEAD_DIM)).reshape(B, T, HG_WIDTH)
    hg_o = hg_o * jax.nn.silu(hgate.astype(f32))
    qk = jax.nn.silu(causal_depthwise_conv(jnp.concatenate([mq, mk], axis=-1), conv_w, conv_b))
    mq, mk = jnp.split(qk.astype(f32), 2, axis=-1)
    qs = (B, T, ML_HEADS, ML_QK_DIM)
    gates = (jnp.concatenate([mig, mfg], axis=-1) + gate_bias).astype(f32)
    log_i = gates[..., :ML_HEADS]
    log_f = jax.nn.log_sigmoid(gates[..., ML_HEADS:])
    ml_o = mlstm_chunkwise(mq.reshape(qs) * (ML_QK_DIM ** -0.5), mk.reshape(qs),
                           mv.astype(f32).reshape(B, T, ML_HEADS, ML_V_DIM), log_i, log_f)
    ml_o = rms_norm(ml_o, ml_norm.reshape(ML_HEADS, ML_V_DIM)).reshape(B, T, ML_WIDTH)
    ml_o = ml_o * jax.nn.sigmoid(mo.astype(f32))
    mix = jnp.concatenate([hg_o, ml_o], axis=-1).astype(h.dtype)
    return mix @ w_out


def setup_inputs(seed: int = 0) -> dict:
    key = jax.random.key(seed)
    ks = jax.random.split(key, 16)
    nrm = jax.random.normal
    gate_bias = jnp.concatenate([
        0.1 * nrm(ks[8], (DEPTH, ML_HEADS)),
        jnp.linspace(3.0, 6.0, ML_HEADS)[None, :] + 0.1 * nrm(ks[9], (DEPTH, ML_HEADS))], axis=-1)
    return {
        "x": nrm(ks[0], (BATCH, SEQ, D_MODEL), jnp.float32),
        "norm_pre": 1.0 + 0.05 * nrm(ks[1], (DEPTH, 3, D_MODEL)),
        "norm_post": 1.0 + 0.05 * nrm(ks[2], (DEPTH, 3, D_MODEL)),
        "ffn1_w_in": nrm(ks[3], (DEPTH, D_MODEL, 2 * D_FF)) * D_MODEL ** -0.5,
        "ffn1_w_out": nrm(ks[4], (DEPTH, D_FF, D_MODEL)) * D_FF ** -0.5,
        "w_mix_in": nrm(ks[5], (DEPTH, D_MODEL, D_IN)) * D_MODEL ** -0.5,
        "conv_w": nrm(ks[6], (DEPTH, CONV_WIDTH, 2 * ML_HEADS * ML_QK_DIM)) * CONV_WIDTH ** -0.5,
        "conv_b": 0.02 * nrm(ks[7], (DEPTH, 2 * ML_HEADS * ML_QK_DIM)),
        "mlstm_gate_bias": gate_bias,
        "hgrn_lb_logits": 0.5 * nrm(ks[10], (DEPTH + 1, HG_WIDTH)),
        "hgrn_norm": 1.0 + 0.05 * nrm(ks[11], (DEPTH, HG_WIDTH)),
        "mlstm_norm": 1.0 + 0.05 * nrm(ks[12], (DEPTH, ML_WIDTH)),
        "w_mix_out": nrm(ks[13], (DEPTH, D_MIX, D_MODEL)) * D_MIX ** -0.5,
        "ffn2_w_in": nrm(ks[14], (DEPTH, D_MODEL, 2 * D_FF)) * D_MODEL ** -0.5,
        "ffn2_w_out": nrm(ks[15], (DEPTH, D_FF, D_MODEL)) * D_FF ** -0.5,
    }


def reference(x, norm_pre, norm_post, ffn1_w_in, ffn1_w_out, w_mix_in, conv_w, conv_b,
              mlstm_gate_bias, hgrn_lb_logits, hgrn_norm, mlstm_norm, w_mix_out,
              ffn2_w_in, ffn2_w_out):
    lower_bounds = jnp.cumsum(jax.nn.softmax(hgrn_lb_logits.astype(jnp.float32), axis=0), axis=0)
    for l in range(DEPTH):
        x = x + 0.5 * rms_norm(swiglu_ffn(rms_norm(x, norm_pre[l, 0]), ffn1_w_in[l], ffn1_w_out[l]),
                               norm_post[l, 0])
        mixed = token_mixer(rms_norm(x, norm_pre[l, 1]), w_mix_in[l], conv_w[l], conv_b[l],
                            mlstm_gate_bias[l], lower_bounds[l], hgrn_norm[l], mlstm_norm[l],
                            w_mix_out[l])
        x = x + rms_norm(mixed, norm_post[l, 1])
        x = x + 0.5 * rms_norm(swiglu_ffn(rms_norm(x, norm_pre[l, 2]), ffn2_w_in[l], ffn2_w_out[l]),
                               norm_post[l, 2])
    return x
```

```cpp
#include <hip/hip_runtime.h>
#include <hip/hip_cooperative_groups.h>
#include <cstdio>
#include <cstdint>
namespace cg = cooperative_groups;
namespace pg8 {
#define PG8_LAS __attribute__((address_space(3)))
typedef unsigned short bf16_t;
typedef short bf16x8 __attribute__((ext_vector_type(8)));
typedef float f32x4 __attribute__((ext_vector_type(4)));
typedef unsigned u32x4 __attribute__((ext_vector_type(4)));
constexpr int BM = 256, BK = 64, HALF = 128, HTB = HALF * BK * 2  , STAGE_BYTES = 8 * HTB, NXCD = 8, WGM = 8;

__host__ __device__ __forceinline__ int lds_byte(int r, int c) { const int st = (r >> 4) * 2 + (c >> 5), rr = r & 15, cc = c & 31, ob = rr * 64 + cc * 2; return st * 1024 + (ob ^ (((ob >> 9) & 1) << 5)); }
__host__ __device__ __forceinline__ void stage_rc(int b, int& R, int& C) { const int st = b / 1024, sb = b % 1024, swz = sb ^ (((sb >> 9) & 1) << 5); R = (st >> 1) * 16 + swz / 64; C = (st & 1) * 32 + (swz % 64) / 2; }
__host__ __device__ __forceinline__ int perm32(int rho) { const int n = rho >> 4, i = rho & 15; return 8 * (i >> 2) + 4 * n + (i & 3); }

struct Unit { int pm, pn; };
struct Gemm { const bf16_t* A; const bf16_t* Bt; int M, N, K; };

struct StaticOrder {
    int nM, nN, nwg, G, c;
    __host__ __device__ void init(int M, int N, int G_, int c_) { nM = M / BM; nN = N / BM; nwg = nM * nN; G = G_; c = c_; }
    __host__ __device__ bool next(int i, Unit& u) const {
        const long L = (long)i * G + c; if (L >= nwg) return false;
        int wgid = (int)L; { const int q = nwg / NXCD, r = nwg % NXCD, xcd = wgid % NXCD, off = wgid / NXCD; wgid = (xcd < r ? xcd * (q + 1) : r * (q + 1) + (xcd - r) * q) + off; }
        const int nig = WGM * nN, gid = wgid / nig, fm = gid * WGM, gsz = (nM - fm) < WGM ? (nM - fm) : WGM;
        u.pm = fm + ((wgid % nig) % gsz); u.pn = (wgid % nig) / gsz; return true;
    }
    __device__ __forceinline__ void a_ready(const Unit&) const {}
    __device__ __forceinline__ void done(const Unit&) const {}
};

__device__ __forceinline__ unsigned cvt_pk_bf16(float lo, float hi) { unsigned r; asm volatile("v_cvt_pk_bf16_f32 %0, %1, %2" : "=v"(r) : "v"(lo), "v"(hi)); return r; }
__device__ __forceinline__ float fsigmoid(float x) { return __builtin_amdgcn_rcpf(1.0f + __expf(-x)); }
struct EpiBf16 {
    static constexpr bool PERM = true, AFTER_DRAIN = false;
    bf16_t* O; int ldc;
    __device__ __forceinline__ void operator()(const f32x4 (&acc)[2][2][4][2], const Unit& u, int wr, int wc, int fr, int fq) const {
        const int row0 = u.pm * BM + wr * 64 + fr; const int col0 = u.pn * BM + wc * 32 + 8 * fq;
#pragma unroll
        for (int ai = 0; ai < 2; ++ai)
#pragma unroll
            for (int m = 0; m < 4; ++m) { bf16_t* rowp = O + (size_t)(row0 + ai * HALF + m * 16) * ldc + col0;
#pragma unroll
                for (int bj = 0; bj < 2; ++bj) { const f32x4 v0 = acc[ai][bj][m][0], v1 = acc[ai][bj][m][1];
                    u32x4 w; w.x = cvt_pk_bf16(v0[0], v0[1]); w.y = cvt_pk_bf16(v0[2], v0[3]); w.z = cvt_pk_bf16(v1[0], v1[1]); w.w = cvt_pk_bf16(v1[2], v1[3]);
                    *(u32x4*)(rowp + bj * HALF) = w; } }
    }
};
struct EpiSwiglu {
    static constexpr bool PERM = true, AFTER_DRAIN = false;
    bf16_t* O; int ldc;
    __device__ __forceinline__ void operator()(const f32x4 (&acc)[2][2][4][2], const Unit& u, int wr, int wc, int fr, int fq) const {
        const int row0 = u.pm * BM + wr * 64 + fr; const int col0 = u.pn * HALF + wc * 32 + 8 * fq;
#pragma unroll
        for (int ai = 0; ai < 2; ++ai)
#pragma unroll
            for (int m = 0; m < 4; ++m) { bf16_t* rowp = O + (size_t)(row0 + ai * HALF + m * 16) * ldc + col0;
                float h[8];
#pragma unroll
                for (int n = 0; n < 2; ++n)
#pragma unroll
                    for (int e = 0; e < 4; ++e) { const float g = acc[ai][0][m][n][e], up = acc[ai][1][m][n][e]; h[n * 4 + e] = g * fsigmoid(g) * up; }
                u32x4 w; w.x = cvt_pk_bf16(h[0], h[1]); w.y = cvt_pk_bf16(h[2], h[3]); w.z = cvt_pk_bf16(h[4], h[5]); w.w = cvt_pk_bf16(h[6], h[7]);
                *(u32x4*)rowp = w; }
    }
};
struct EpiF32Part {
    static constexpr bool PERM = false, AFTER_DRAIN = false;
    float* Y; int ldc; float* part;
    __device__ __forceinline__ void operator()(const f32x4 (&acc)[2][2][4][2], const Unit& u, int wr, int wc, int fr, int fq) const {
        const int row0 = u.pm * BM + wr * 64 + fr; const int col0 = u.pn * BM + wc * 32 + 4 * fq;
#pragma unroll
        for (int ai = 0; ai < 2; ++ai)
#pragma unroll
            for (int m = 0; m < 4; ++m) { const int row = row0 + ai * HALF + m * 16; float* rowp = Y + (size_t)row * ldc + col0; float ss = 0.f;
#pragma unroll
                for (int bj = 0; bj < 2; ++bj)
#pragma unroll
                    for (int n = 0; n < 2; ++n) { const f32x4 v = acc[ai][bj][m][n]; ss += (v[0] * v[0] + v[1] * v[1]) + (v[2] * v[2] + v[3] * v[3]); *(f32x4*)(rowp + bj * HALF + n * 16) = v; }
                ss += __shfl_xor(ss, 16); ss += __shfl_xor(ss, 32);
                if (fq == 0) part[(size_t)row * 16 + u.pn * 4 + wc] = ss; }
    }
};

template <class Epi, class Sched, bool ALIGN_EPI = false, bool SP2 = false>
__device__ __forceinline__ void gemm_phase(PG8_LAS unsigned char* lds, const Gemm g, const Sched& S, const Epi& E) {
    const int tid = threadIdx.x, wid = __builtin_amdgcn_readfirstlane(tid >> 6), lane = tid & 63, wr = wid >> 2, wc = wid & 3, fr = lane & 15, fq = lane >> 4;
    const int K = g.K, nt = K / BK;
    unsigned voffA[2], voffB[2];
#pragma unroll
    for (int i = 0; i < 2; ++i) { int R, C; stage_rc(tid * 16 + i * 8192, R, C); const int Rb = Epi::PERM ? ((R & ~31) + perm32(R & 31)) : R;
        voffA[i] = (unsigned)(R * K + C) * 2u; voffB[i] = (unsigned)(Rb * K + C) * 2u; }
    const size_t kstep = (size_t)(BK * 2);
    const size_t hstep = (size_t)HALF * K * 2;
    const size_t tstep = 2 * hstep;
    const unsigned ldsw = (unsigned)wid * 1024u;
    const int aoff = lds_byte(wr * 64 + fr, fq * 8), boff = lds_byte(wc * 32 + fr, fq * 8);
#define PG8_SA(b, h) (((b) * 2 + (h)) * HTB)
#define PG8_SB(b, h) ((4 + (b) * 2 + (h)) * HTB)
#define PG8_STAGE(bufoff, gbase, voff) do { _Pragma("unroll") for (int _i = 0; _i < 2; ++_i) \
        __builtin_amdgcn_global_load_lds((const unsigned*)((const char*)(gbase) + (voff)[_i]), (PG8_LAS unsigned*)(lds + (bufoff) + ldsw + _i * 8192), 16, 0, 0); } while (0)
#define PG8_LDA(dst, b, h) do { _Pragma("unroll") for (int m = 0; m < 4; ++m) _Pragma("unroll") for (int k = 0; k < 2; ++k) dst[m][k] = *(const PG8_LAS bf16x8*)(lds + PG8_SA(b, h) + aoff + m * 2048 + k * 1024); } while (0)
#define PG8_LDB(dst, b, h) do { _Pragma("unroll") for (int n = 0; n < 2; ++n) _Pragma("unroll") for (int k = 0; k < 2; ++k) dst[n][k] = *(const PG8_LAS bf16x8*)(lds + PG8_SB(b, h) + boff + n * 2048 + k * 1024); } while (0)
#define PG8_MMA(ai, bj, At, Bt) do { __builtin_amdgcn_s_setprio(1); _Pragma("unroll") for (int m = 0; m < 4; ++m) _Pragma("unroll") for (int n = 0; n < 2; ++n) _Pragma("unroll") for (int k = 0; k < 2; ++k) \
        acc[ai][bj][m][n] = __builtin_amdgcn_mfma_f32_16x16x32_bf16(Bt[n][k], At[m][k], acc[ai][bj][m][n], 0, 0, 0); __builtin_amdgcn_s_setprio(0); } while (0)
#define PG8_WAIT_V(n) asm volatile("s_waitcnt vmcnt(" #n ")" ::: "memory")
#define PG8_WAIT_L(n) asm volatile("s_waitcnt lgkmcnt(" #n ")" ::: "memory")
#define PG8_BAR __builtin_amdgcn_s_barrier()
#define PG8_SCHED __builtin_amdgcn_sched_barrier(0)
    Unit cur, nxt; int ui = 0;
    if (!S.next(0, cur)) return;
    f32x4 acc[2][2][4][2];
#pragma unroll
    for (int a = 0; a < 2; ++a)
#pragma unroll
        for (int b = 0; b < 2; ++b)
#pragma unroll
            for (int m = 0; m < 4; ++m)
#pragma unroll
                for (int n = 0; n < 2; ++n) acc[a][b][m][n] = (f32x4){0.f, 0.f, 0.f, 0.f};
    bf16x8 At[4][2], B0[2][2], B1[2][2];
    const char* cA = (const char*)g.A + (size_t)cur.pm * tstep; const char* cB = (const char*)g.Bt + (size_t)cur.pn * tstep;
    S.a_ready(cur);
    if constexpr (SP2) {
        PG8_STAGE(PG8_SB(0, 0), cB, voffB); PG8_STAGE(PG8_SB(0, 1), cB + hstep, voffB); PG8_STAGE(PG8_SA(0, 0), cA, voffA); PG8_STAGE(PG8_SA(0, 1), cA + hstep, voffA);
        if (wr == 1) PG8_BAR;
        PG8_WAIT_V(2); PG8_BAR;
        PG8_STAGE(PG8_SB(1, 0), cB + kstep, voffB); PG8_STAGE(PG8_SA(1, 0), cA + kstep, voffA); PG8_STAGE(PG8_SB(1, 1), cB + hstep + kstep, voffB);
        PG8_WAIT_V(6); PG8_BAR;
    } else {
        PG8_STAGE(PG8_SB(0, 0), cB, voffB); PG8_STAGE(PG8_SA(0, 0), cA, voffA); PG8_STAGE(PG8_SB(0, 1), cB + hstep, voffB); PG8_STAGE(PG8_SA(0, 1), cA + hstep, voffA);
        if (wr == 1) PG8_BAR;
        PG8_WAIT_V(4); PG8_BAR;
        PG8_STAGE(PG8_SB(1, 0), cB + kstep, voffB); PG8_STAGE(PG8_SA(1, 0), cA + kstep, voffA); PG8_STAGE(PG8_SB(1, 1), cB + hstep + kstep, voffB);
        PG8_WAIT_V(6); PG8_BAR;
    }
    for (;;) {
        const bool has_next = S.next(ui + 1, nxt);
        const char* nA = has_next ? (const char*)g.A + (size_t)nxt.pm * tstep : cA; const char* nB = has_next ? (const char*)g.Bt + (size_t)nxt.pn * tstep : cB;
        for (int t = 0; t < nt; t += 2) {
            const bool last = (t == nt - 2);
            const char* a1 = cA + (size_t)(t + 1) * kstep;
            const char* a2 = last ? nA : cA + (size_t)(t + 2) * kstep; const char* b2 = last ? nB : cB + (size_t)(t + 2) * kstep;
            const char* a3 = a2 + kstep; const char* b3 = b2 + kstep;
            if (last && has_next) S.a_ready(nxt);
            if constexpr (SP2) {
            PG8_LDB(B0, 0, 0); PG8_LDB(B1, 0, 1); PG8_SCHED; PG8_LDA(At, 0, 0); PG8_STAGE(PG8_SA(1, 1), a1 + hstep, voffA);
            PG8_WAIT_V(8); PG8_WAIT_L(0); PG8_BAR; PG8_MMA(0, 0, At, B0); PG8_MMA(0, 1, At, B1); PG8_BAR; PG8_SCHED;
            PG8_LDA(At, 0, 1); PG8_STAGE(PG8_SB(0, 0), b2, voffB); PG8_STAGE(PG8_SB(0, 1), b2 + hstep, voffB); PG8_STAGE(PG8_SA(0, 0), a2, voffA);
            PG8_WAIT_V(8); PG8_WAIT_L(0); PG8_BAR; PG8_MMA(1, 0, At, B0); PG8_MMA(1, 1, At, B1); PG8_BAR; PG8_SCHED;
            PG8_LDB(B0, 1, 0); PG8_LDB(B1, 1, 1); PG8_SCHED; PG8_LDA(At, 1, 0); PG8_STAGE(PG8_SA(0, 1), a2 + hstep, voffA);
            PG8_WAIT_V(8); PG8_WAIT_L(0); PG8_BAR; PG8_MMA(0, 0, At, B0); PG8_MMA(0, 1, At, B1); PG8_BAR; PG8_SCHED;
            PG8_LDA(At, 1, 1); PG8_STAGE(PG8_SB(1, 0), b3, voffB); PG8_STAGE(PG8_SB(1, 1), b3 + hstep, voffB); PG8_STAGE(PG8_SA(1, 0), a3, voffA);
            PG8_WAIT_V(8); PG8_WAIT_L(0); PG8_BAR; PG8_MMA(1, 0, At, B0); PG8_MMA(1, 1, At, B1); PG8_BAR; PG8_SCHED;
            } else {
            PG8_LDB(B0, 0, 0); PG8_SCHED; PG8_LDA(At, 0, 0); PG8_STAGE(PG8_SA(1, 1), a1 + hstep, voffA);
            PG8_WAIT_L(8); PG8_BAR; PG8_WAIT_L(0); PG8_MMA(0, 0, At, B0); PG8_BAR; PG8_SCHED;
            PG8_LDB(B1, 0, 1); PG8_STAGE(PG8_SB(0, 0), b2, voffB);
            PG8_BAR; PG8_WAIT_L(0); PG8_MMA(0, 1, At, B1); PG8_BAR;
            PG8_LDA(At, 0, 1); PG8_STAGE(PG8_SA(0, 0), a2, voffA);
            PG8_BAR; PG8_WAIT_L(0); PG8_MMA(1, 0, At, B0); PG8_BAR; PG8_SCHED;
            PG8_STAGE(PG8_SB(0, 1), b2 + hstep, voffB);
            PG8_WAIT_V(6); PG8_BAR; PG8_MMA(1, 1, At, B1); PG8_BAR;
            PG8_LDB(B0, 1, 0); PG8_SCHED; PG8_LDA(At, 1, 0); PG8_STAGE(PG8_SA(0, 1), a2 + hstep, voffA);
            PG8_WAIT_L(8); PG8_BAR; PG8_WAIT_L(0); PG8_MMA(0, 0, At, B0); PG8_BAR; PG8_SCHED;
            PG8_LDB(B1, 1, 1); PG8_STAGE(PG8_SB(1, 0), b3, voffB);
            PG8_BAR; PG8_WAIT_L(0); PG8_MMA(0, 1, At, B1); PG8_BAR;
            PG8_LDA(At, 1, 1); PG8_STAGE(PG8_SA(1, 0), a3, voffA);
            PG8_BAR; PG8_WAIT_L(0); PG8_MMA(1, 0, At, B0); PG8_BAR; PG8_SCHED;
            PG8_STAGE(PG8_SB(1, 1), b3 + hstep, voffB);
            PG8_WAIT_V(6); PG8_BAR; PG8_MMA(1, 1, At, B1); PG8_BAR;
            }
        }
        if constexpr (ALIGN_EPI) { if (wr == 0) PG8_BAR; }
        if constexpr (!Epi::AFTER_DRAIN) { E(acc, cur, wr, wc, fr, fq); S.done(cur); }
        if (!has_next) break;
#pragma unroll
        for (int a = 0; a < 2; ++a)
#pragma unroll
            for (int b = 0; b < 2; ++b)
#pragma unroll
                for (int m = 0; m < 4; ++m)
#pragma unroll
                    for (int n = 0; n < 2; ++n) acc[a][b][m][n] = (f32x4){0.f, 0.f, 0.f, 0.f};
        cur = nxt; cA = nA; cB = nB; ++ui;
        if constexpr (ALIGN_EPI) { if (wr == 1) PG8_BAR; }
    }
    PG8_WAIT_V(0);
    if constexpr (!ALIGN_EPI) { if (wr == 0) PG8_BAR; }
    PG8_BAR;
    if constexpr (Epi::AFTER_DRAIN) { E.fused(acc, cur, wr, wc, fr, fq, lds, wid, lane); S.done(cur); }
#undef PG8_SA
#undef PG8_SB
#undef PG8_STAGE
#undef PG8_LDA
#undef PG8_LDB
#undef PG8_MMA
#undef PG8_WAIT_V
#undef PG8_WAIT_L
#undef PG8_BAR
#undef PG8_SCHED
}
}
#ifndef PG8_SP2
#define PG8_SP2 true
#endif
#ifndef PG8_ALIGN
#define PG8_ALIGN true
#endif
#ifndef MK_COOP
#define MK_COOP 1
#endif

constexpr int NWAVES = 8, NTHR = NWAVES * 64;
constexpr int BATCH = 4, SEQ = 4096, M = BATCH * SEQ, D = 1024, FF = 2816, NMI = 3584, LDMI = 3592;
constexpr float EPS = 1e-6f;
constexpr int NPHASE = 13;
constexpr size_t KiB = 1024, MiB = 1u << 20;
constexpr size_t WS_PART = 0, WS_GATES = 1 * MiB, WS_DEC = 1 * MiB + 512 * KiB;
constexpr size_t WS_W1I = 3 * MiB, WS_W1O = 14 * MiB, WS_WMI = 19 * MiB + 512 * KiB, WS_WMO = 26 * MiB + 512 * KiB, WS_W2I = 28 * MiB + 512 * KiB, WS_W2O = 39 * MiB + 512 * KiB;
constexpr size_t WS_XN = 45 * MiB;
constexpr size_t WS_ACT = 77 * MiB, WS_Y = 165 * MiB;
constexpr size_t WS_P = 77 * MiB, WS_S = 189 * MiB;
constexpr size_t WS_END = 239 * MiB;
constexpr int LDS_BYTES = 147456;

typedef unsigned short bf16;
typedef float f32x4 __attribute__((ext_vector_type(4)));
typedef unsigned u32x4 __attribute__((ext_vector_type(4)));
typedef unsigned u32x2 __attribute__((ext_vector_type(2)));
#define LAS __attribute__((address_space(3)))

__device__ __forceinline__ float wave_sum(float v) {
#pragma unroll
    for (int o = 1; o < 64; o <<= 1) v += __shfl_xor(v, o);
    return v;
}
__device__ __forceinline__ unsigned pk2(float lo, float hi) { return pg8::cvt_pk_bf16(lo, hi); }
__device__ __forceinline__ void unpack8(const u32x4 w, float (&f)[8]) {
    f[0] = __uint_as_float(w.x << 16); f[1] = __uint_as_float(w.x & 0xffff0000u); f[2] = __uint_as_float(w.y << 16); f[3] = __uint_as_float(w.y & 0xffff0000u);
    f[4] = __uint_as_float(w.z << 16); f[5] = __uint_as_float(w.z & 0xffff0000u); f[6] = __uint_as_float(w.w << 16); f[7] = __uint_as_float(w.w & 0xffff0000u);
}
__device__ __forceinline__ float sigm(float x) { return 1.0f / (1.0f + __expf(-x)); }

template <int MODE>
__device__ __forceinline__ void transpose_item(const float* W, int K, int ldw, int ncols, bf16* WT, float* scr, int item, int lane) {
    const int nblk = ncols / 32, kb = item / nblk, nb = item % nblk, k0 = 64 * kb, n0 = 32 * nb;
#pragma unroll 8
    for (int i = 0; i < 32; ++i) { const int kk = 2 * i + (lane >> 5); scr[kk * 33 + (lane & 31)] = W[(size_t)(k0 + kk) * ldw + n0 + (lane & 31)]; }
    asm volatile("s_waitcnt lgkmcnt(0)" ::: "memory");
    int d0 = n0;
    if (MODE == 1) { if (n0 < FF) d0 = 256 * (n0 / 128) + (n0 % 128); else { const int jj = n0 - FF; d0 = 256 * (jj / 128) + 128 + (jj % 128); } }
    const int c = lane & 7;
#pragma unroll
    for (int j = 0; j < 4; ++j) { const int n = (lane >> 3) + 8 * j; const float* s = scr + (8 * c) * 33 + n;
        u32x4 o; o.x = pk2(s[0 * 33], s[1 * 33]); o.y = pk2(s[2 * 33], s[3 * 33]); o.z = pk2(s[4 * 33], s[5 * 33]); o.w = pk2(s[6 * 33], s[7 * 33]);
        *(u32x4*)(WT + (size_t)(d0 + n) * K + k0 + 8 * c) = o; }
    asm volatile("s_waitcnt lgkmcnt(0)" ::: "memory");
}

__device__ __forceinline__ void norm_rows(int gw, int NGW, int lane, const float* xres, const float* y, const float* part, float alpha, const float* g_post,
                                          float* xout, const float* g_pre, bf16* hn, const float* w8, const float* gate_bias, float* gates_out) {
    for (int m = gw; m < M; m += NGW) {
        f32x4 v[4];
        const f32x4* xr = (const f32x4*)(xres + (size_t)m * D) + lane;
#pragma unroll
        for (int j = 0; j < 4; ++j) v[j] = xr[64 * j];
        if (y) {
            float ps = part[(size_t)m * 16 + (lane & 15)];
            ps += __shfl_xor(ps, 1); ps += __shfl_xor(ps, 2); ps += __shfl_xor(ps, 4); ps += __shfl_xor(ps, 8);
            const float rs = rsqrtf(ps * (1.0f / D) + EPS) * alpha;
            const f32x4* yr = (const f32x4*)(y + (size_t)m * D) + lane; const f32x4* gp = (const f32x4*)g_post + lane;
#pragma unroll
            for (int j = 0; j < 4; ++j) { const f32x4 yy = yr[64 * j], gg = gp[64 * j]; v[j] = v[j] + yy * gg * rs; }
        }
        if (xout) { f32x4* xo = (f32x4*)(xout + (size_t)m * D) + lane;
#pragma unroll
            for (int j = 0; j < 4; ++j) xo[64 * j] = v[j]; }
        if (hn) {
            float s2 = 0.f;
#pragma unroll
            for (int j = 0; j < 4; ++j) s2 += (v[j].x * v[j].x + v[j].y * v[j].y) + (v[j].z * v[j].z + v[j].w * v[j].w);
            s2 = wave_sum(s2);
            const float r = rsqrtf(s2 * (1.0f / D) + EPS);
            const f32x4* gq = (const f32x4*)g_pre + lane;
            u32x2* o8 = (u32x2*)(hn + (size_t)m * D) + lane;
#pragma unroll
            for (int j = 0; j < 4; ++j) { const f32x4 gg = gq[64 * j]; v[j] = v[j] * gg * r; u32x2 w; w.x = pk2(v[j].x, v[j].y); w.y = pk2(v[j].z, v[j].w); o8[64 * j] = w; }
            if (gates_out) {
                float d[8];
#pragma unroll
                for (int c = 0; c < 8; ++c) d[c] = 0.f;
#pragma unroll
                for (int j = 0; j < 4; ++j)
#pragma unroll
                    for (int e = 0; e < 4; ++e) { const int k = 4 * (64 * j + lane) + e; const f32x4 wa = *(const f32x4*)(w8 + k * 8), wb = *(const f32x4*)(w8 + k * 8 + 4); const float hv = v[j][e];
                        d[0] += hv * wa.x; d[1] += hv * wa.y; d[2] += hv * wa.z; d[3] += hv * wa.w; d[4] += hv * wb.x; d[5] += hv * wb.y; d[6] += hv * wb.z; d[7] += hv * wb.w; }
#pragma unroll
                for (int c = 0; c < 8; ++c) d[c] = wave_sum(d[c]);
                float o = d[0];
#pragma unroll
                for (int c = 1; c < 8; ++c) o = (lane == c) ? d[c] : o;
                if (lane < 8) gates_out[(size_t)m * 8 + lane] = o + gate_bias[lane];
            }
        }
    }
}

struct MixArgs { const bf16* P; const float* gates; const float* lbl; const float* conv_w; const float* conv_b; const float* hg_norm; const float* ml_norm; bf16* mix; };
template <int TY>
__device__ __forceinline__ void load_qkf(const MixArgs& A, int b, int h, int tl, int o, float (&q)[8], float (&kk)[8], float (&lf)[8]) {
    const size_t row = (size_t)b * SEQ + tl;
    if (TY == 0) {
        const int col = h * 128 + 8 * o;
        float hq[8], hf[8];
        unpack8(*(const u32x4*)(A.P + row * NMI + col), hq); unpack8(*(const u32x4*)(A.P + row * NMI + 512 + col), hf);
#pragma unroll
        for (int e = 0; e < 8; ++e) {
            const float lbv = sigm(A.lbl[col + e] - A.lbl[512 + col + e]);
            q[e] = hq[e] * sigm(hq[e]);
            const float f = lbv + (1.0f - lbv) * sigm(hf[e]);
            kk[e] = (1.0f - lbv) * sigm(-hf[e]);
            lf[e] = __logf(f);
        }
    } else {
        const int col = h * 64 + 8 * o;
        float aq[8], ak[8];
#pragma unroll
        for (int e = 0; e < 8; ++e) { aq[e] = A.conv_b[col + e]; ak[e] = A.conv_b[256 + col + e]; }
#pragma unroll
        for (int j = 0; j < 4; ++j) {
            const int tt = tl - 3 + j;
            if (tt >= 0) {
                float xq[8], xk[8];
                const size_t r2 = (size_t)b * SEQ + tt;
                unpack8(*(const u32x4*)(A.P + r2 * NMI + 2048 + col), xq); unpack8(*(const u32x4*)(A.P + r2 * NMI + 2304 + col), xk);
#pragma unroll
                for (int e = 0; e < 8; ++e) { aq[e] += A.conv_w[j * 512 + col + e] * xq[e]; ak[e] += A.conv_w[j * 512 + 256 + col + e] * xk[e]; }
            }
        }
        const float li = A.gates[row * 8 + h], fg = A.gates[row * 8 + 4 + h];
        const float ei = __expf(li);
        const float lfv = fminf(fg, 0.f) - log1pf(__expf(-fabsf(fg)));
#pragma unroll
        for (int e = 0; e < 8; ++e) { q[e] = aq[e] * sigm(aq[e]) * 0.125f; kk[e] = ak[e] * sigm(ak[e]) * ei; lf[e] = lfv; }
    }
}
template <int TY>
__device__ __forceinline__ void mix_epilogue(const float* OO, const float* DEN, int R, const MixArgs& A, int b, int h, int t0, int tid) {
    for (int idx = tid; idx < R * 16; idx += NTHR) {
        const int row = idx >> 4, part = idx & 15;
        float o[8];
        { const f32x4 a = *(const f32x4*)(OO + row * 128 + part * 8), c = *(const f32x4*)(OO + row * 128 + part * 8 + 4); o[0] = a.x; o[1] = a.y; o[2] = a.z; o[3] = a.w; o[4] = c.x; o[5] = c.y; o[6] = c.z; o[7] = c.w; }
        float sc = 1.0f;
        if (TY == 1) sc = 1.0f / fmaxf(fabsf(DEN[row]), 1.0f);
        float ss = 0.f;
#pragma unroll
        for (int e = 0; e < 8; ++e) { o[e] *= sc; ss += o[e] * o[e]; }
        ss += __shfl_xor(ss, 1); ss += __shfl_xor(ss, 2); ss += __shfl_xor(ss, 4); ss += __shfl_xor(ss, 8);
        const float r = rsqrtf(ss * (1.0f / 128.0f) + EPS);
        const size_t grow = (size_t)b * SEQ + t0 + row;
        float g[8];
        unpack8(*(const u32x4*)(A.P + grow * NMI + (TY == 0 ? 1536 : 3072) + h * 128 + part * 8), g);
        const float* nw = (TY == 0 ? A.hg_norm : A.ml_norm) + h * 128 + part * 8;
#pragma unroll
        for (int e = 0; e < 8; ++e) { const float gv = (TY == 0) ? g[e] * sigm(g[e]) : sigm(g[e]); o[e] = o[e] * r * nw[e] * gv; }
        u32x4 w; w.x = pk2(o[0], o[1]); w.y = pk2(o[2], o[3]); w.z = pk2(o[4], o[5]); w.w = pk2(o[6], o[7]);
        *(u32x4*)(A.mix + grow * D + TY * 512 + h * 128 + part * 8) = w;
    }
}
template <int TY>
__device__ __forceinline__ void mixer_recurrent(float* ldsf, const MixArgs& A, int b, int h, int tid) {
    constexpr int DK = TY == 0 ? 128 : 64, KPT = DK / 4, OCT = DK / 8, R = 32;
    float* QQ = ldsf; float* KK = QQ + R * DK; float* FFt = KK + R * DK; float* VV = FFt + R * DK; float* OO = VV + R * 128; float* DEN = OO + R * 128;
    const int lane = tid & 63, wave = tid >> 6, v = wave * 16 + (lane & 15), kg = lane >> 4;
    float S[KPT], N[KPT];
#pragma unroll
    for (int i = 0; i < KPT; ++i) { S[i] = 0.f; N[i] = 0.f; }
    for (int sc = 0; sc < SEQ / R; ++sc) {
        const int t0 = sc * R;
        for (int idx = tid; idx < R * OCT; idx += NTHR) {
            const int row = idx / OCT, o = idx % OCT; float q[8], kk[8], lf[8];
            load_qkf<TY>(A, b, h, t0 + row, o, q, kk, lf);
#pragma unroll
            for (int e = 0; e < 8; ++e) { QQ[row * DK + 8 * o + e] = q[e]; KK[row * DK + 8 * o + e] = kk[e]; FFt[row * DK + 8 * o + e] = __expf(lf[e]); }
        }
        { const int row = tid >> 4, o = tid & 15; float vv[8];
          unpack8(*(const u32x4*)(A.P + ((size_t)b * SEQ + t0 + row) * NMI + (TY == 0 ? 1024 : 2560) + h * 128 + 8 * o), vv);
#pragma unroll
          for (int e = 0; e < 8; ++e) VV[row * 128 + 8 * o + e] = vv[e]; }
        __syncthreads();
        for (int s = 0; s < R; ++s) {
            const float vv = VV[s * 128 + v]; float o = 0.f, dn = 0.f;
#pragma unroll
            for (int i = 0; i < KPT; ++i) { const int k = kg * KPT + i; const float f = FFt[s * DK + k], kx = KK[s * DK + k], qx = QQ[s * DK + k];
                S[i] = f * S[i] + kx * vv; o += qx * S[i];
                if (TY == 1) { N[i] = f * N[i] + kx; dn += qx * N[i]; } }
            o += __shfl_xor(o, 16); o += __shfl_xor(o, 32);
            if (kg == 0) OO[s * 128 + v] = o;
            if (TY == 1) { dn += __shfl_xor(dn, 16); dn += __shfl_xor(dn, 32); if (tid == 0) DEN[s] = dn; }
        }
        __syncthreads();
        mix_epilogue<TY>(OO, DEN, R, A, b, h, t0, tid);
        __syncthreads();
    }
}

struct Args { const float* in[15]; float* out; unsigned char* ws; int ph_lo, ph_hi; };
__global__ void __launch_bounds__(NTHR, 2) fwd(Args args) {
    extern __shared__ __attribute__((aligned(16))) unsigned char lds[];
    cg::grid_group grid = cg::this_grid();
    const int tid = threadIdx.x, lane = tid & 63, wave = __builtin_amdgcn_readfirstlane(tid >> 6);
    const int G = gridDim.x, bx = blockIdx.x;
    const int gw = bx * NWAVES + wave, NGW = G * NWAVES;
    unsigned char* ws = args.ws;
    const float* x = args.in[0]; const float* norm_pre = args.in[1]; const float* norm_post = args.in[2];
    float* out = args.out;
    bf16* W1I = (bf16*)(ws + WS_W1I); bf16* W1O = (bf16*)(ws + WS_W1O); bf16* WMI = (bf16*)(ws + WS_WMI); bf16* WMO = (bf16*)(ws + WS_WMO); bf16* W2I = (bf16*)(ws + WS_W2I); bf16* W2O = (bf16*)(ws + WS_W2O);
    bf16* XN = (bf16*)(ws + WS_XN); bf16* ACT = (bf16*)(ws + WS_ACT); float* Y = (float*)(ws + WS_Y); bf16* P = (bf16*)(ws + WS_P);
    float* PART = (float*)(ws + WS_PART); float* GATES = (float*)(ws + WS_GATES);
    LAS unsigned char* ldsl = (LAS unsigned char*)lds;
    const int lo = args.ph_lo, hi = args.ph_hi;
#define IN(k) (lo <= (k) && (k) < hi)
#define SEAM(k) do { if (IN(k) && IN((k) + 1)) grid.sync(); } while (0)

    if (IN(0)) {
        float* scr = (float*)(lds + wave * 16384);
        constexpr int I_FI = (D / 64) * (2 * FF / 32), I_FO = (FF / 64) * (D / 32), I_MI = (D / 64) * (NMI / 32), I_MO = (D / 64) * (D / 32);
        constexpr int NITEMS = 2 * I_FI + 2 * I_FO + I_MI + I_MO;
        for (int it = gw; it < NITEMS; it += NGW) {
            int r = it;
            if (r < I_FI) { transpose_item<1>(args.in[3], D, 2 * FF, 2 * FF, W1I, scr, r, lane); continue; } r -= I_FI;
            if (r < I_FI) { transpose_item<1>(args.in[13], D, 2 * FF, 2 * FF, W2I, scr, r, lane); continue; } r -= I_FI;
            if (r < I_FO) { transpose_item<0>(args.in[4], FF, D, D, W1O, scr, r, lane); continue; } r -= I_FO;
            if (r < I_FO) { transpose_item<0>(args.in[14], FF, D, D, W2O, scr, r, lane); continue; } r -= I_FO;
            if (r < I_MI) { transpose_item<0>(args.in[5], D, LDMI, NMI, WMI, scr, r, lane); continue; } r -= I_MI;
            transpose_item<0>(args.in[12], D, D, D, WMO, scr, r, lane);
        }
        norm_rows(gw, NGW, lane, x, nullptr, nullptr, 0.f, nullptr, nullptr, norm_pre, XN, nullptr, nullptr, nullptr);
    }
    SEAM(0);
    if (IN(1)) {
        pg8::Gemm g{XN, W1I, M, 2 * FF, D}; pg8::StaticOrder S; S.init(M, 2 * FF, G, bx);
        pg8::EpiSwiglu E{ACT, FF};
        pg8::gemm_phase<pg8::EpiSwiglu, pg8::StaticOrder, PG8_ALIGN, PG8_SP2>(ldsl, g, S, E);
    }
    SEAM(1);
    if (IN(2)) {
        pg8::Gemm g{ACT, W1O, M, D, FF}; pg8::StaticOrder S; S.init(M, D, G, bx);
        pg8::EpiF32Part E{Y, D, PART};
        pg8::gemm_phase<pg8::EpiF32Part, pg8::StaticOrder, PG8_ALIGN, PG8_SP2>(ldsl, g, S, E);
    }
    SEAM(2);
    if (IN(3)) {
        float* w8 = (float*)lds;
        for (int i = tid; i < D * 8; i += NTHR) w8[i] = args.in[5][(size_t)(i >> 3) * LDMI + NMI + (i & 7)];
        __syncthreads();
        norm_rows(gw, NGW, lane, x, Y, PART, 0.5f, norm_post, out, norm_pre + D, XN, w8, args.in[8], GATES);
        __syncthreads();
    }
    SEAM(3);
    if (IN(4)) {
        pg8::Gemm g{XN, WMI, M, NMI, D}; pg8::StaticOrder S; S.init(M, NMI, G, bx);
        pg8::EpiBf16 E{P, NMI};
        pg8::gemm_phase<pg8::EpiBf16, pg8::StaticOrder, PG8_ALIGN, PG8_SP2>(ldsl, g, S, E);
    }
    SEAM(4);
    const MixArgs MA{P, GATES, args.in[9], args.in[6], args.in[7], args.in[10], args.in[11], XN};
    if (IN(5)) {
        if (bx < 32) { const int ty = bx >> 4, b = (bx >> 2) & 3, h = bx & 3;
            if (ty == 0) mixer_recurrent<0>((float*)lds, MA, b, h, tid); else mixer_recurrent<1>((float*)lds, MA, b, h, tid); }
    }
    SEAM(5);
    SEAM(6);
    SEAM(7);
    if (IN(8)) {
        pg8::Gemm g{XN, WMO, M, D, D}; pg8::StaticOrder S; S.init(M, D, G, bx);
        pg8::EpiF32Part E{Y, D, PART};
        pg8::gemm_phase<pg8::EpiF32Part, pg8::StaticOrder, PG8_ALIGN, PG8_SP2>(ldsl, g, S, E);
    }
    SEAM(8);
    if (IN(9)) norm_rows(gw, NGW, lane, out, Y, PART, 1.0f, norm_post + D, out, norm_pre + 2 * D, XN, nullptr, nullptr, nullptr);
    SEAM(9);
    if (IN(10)) {
        pg8::Gemm g{XN, W2I, M, 2 * FF, D}; pg8::StaticOrder S; S.init(M, 2 * FF, G, bx);
        pg8::EpiSwiglu E{ACT, FF};
        pg8::gemm_phase<pg8::EpiSwiglu, pg8::StaticOrder, PG8_ALIGN, PG8_SP2>(ldsl, g, S, E);
    }
    SEAM(10);
    if (IN(11)) {
        pg8::Gemm g{ACT, W2O, M, D, FF}; pg8::StaticOrder S; S.init(M, D, G, bx);
        pg8::EpiF32Part E{Y, D, PART};
        pg8::gemm_phase<pg8::EpiF32Part, pg8::StaticOrder, PG8_ALIGN, PG8_SP2>(ldsl, g, S, E);
    }
    SEAM(11);
    if (IN(12)) norm_rows(gw, NGW, lane, out, Y, PART, 0.5f, norm_post + 2 * D, out, nullptr, nullptr, nullptr, nullptr, nullptr);
#undef IN
#undef SEAM
}

extern "C" void kernel_launch(void* const* d_in, const int* in_sizes, int n_in, void* d_out, int out_size, void* d_ws, size_t ws_size, hipStream_t stream) {
    static int grid = 0;
    if (grid == 0) {
        if (n_in != 15 || out_size != M * D || ws_size < WS_END) { fprintf(stderr, "kernel_launch: unexpected shapes (n_in %d, out %d, ws %zu); nothing launched\n", n_in, out_size, ws_size); grid = -1; return; }
        int dev = 0, cus = 0, per_cu = 0;
        (void)hipGetDevice(&dev); (void)hipDeviceGetAttribute(&cus, hipDeviceAttributeMultiprocessorCount, dev);
        if (hipFuncSetAttribute((const void*)fwd, hipFuncAttributeMaxDynamicSharedMemorySize, LDS_BYTES) != hipSuccess) { fprintf(stderr, "kernel_launch: hipFuncSetAttribute failed\n"); grid = -1; return; }
        if (hipOccupancyMaxActiveBlocksPerMultiprocessor(&per_cu, (const void*)fwd, NTHR, LDS_BYTES) != hipSuccess || per_cu < 1) { fprintf(stderr, "kernel_launch: occupancy query says %d\n", per_cu); per_cu = 1; }
        (void)hipGetLastError();
        grid = cus * per_cu;
    }
    if (grid < 0) return;
    Args a{};
    for (int i = 0; i < 15; ++i) a.in[i] = (const float*)d_in[i];
    a.out = (float*)d_out; a.ws = (unsigned char*)d_ws;
#if MK_COOP
    a.ph_lo = 0; a.ph_hi = NPHASE;
    void* kargs[] = {&a};
    hipError_t e = hipLaunchCooperativeKernel((const void*)fwd, dim3(grid), dim3(NTHR), kargs, LDS_BYTES, stream);
    if (e != hipSuccess) fprintf(stderr, "cooperative launch failed: %s (grid %d)\n", hipGetErrorString(e), grid);
#else
    for (int k = 0; k < NPHASE; ++k) {
        if (k == 6 || k == 7) continue;
        a.ph_lo = k; a.ph_hi = k + 1;
        hipLaunchKernelGGL(fwd, dim3(grid), dim3(NTHR), LDS_BYTES, stream, a);
    }
#endif
}
```

```cpp
#include <hip/hip_runtime.h>
#include <hip/hip_cooperative_groups.h>
#include <cstdio>
#include <cstdint>
namespace cg = cooperative_groups;
namespace pg8 {
#define PG8_LAS __attribute__((address_space(3)))
typedef unsigned short bf16_t;
typedef short bf16x8 __attribute__((ext_vector_type(8)));
typedef float f32x4 __attribute__((ext_vector_type(4)));
typedef unsigned u32x4 __attribute__((ext_vector_type(4)));
constexpr int BM = 256, BK = 64, HALF = 128, HTB = HALF * BK * 2  , STAGE_BYTES = 8 * HTB, NXCD = 8, WGM = 8;

__host__ __device__ __forceinline__ int lds_byte(int r, int c) { const int st = (r >> 4) * 2 + (c >> 5), rr = r & 15, cc = c & 31, ob = rr * 64 + cc * 2; return st * 1024 + (ob ^ (((ob >> 9) & 1) << 5)); }
__host__ __device__ __forceinline__ void stage_rc(int b, int& R, int& C) { const int st = b / 1024, sb = b % 1024, swz = sb ^ (((sb >> 9) & 1) << 5); R = (st >> 1) * 16 + swz / 64; C = (st & 1) * 32 + (swz % 64) / 2; }
__host__ __device__ __forceinline__ int perm32(int rho) { const int n = rho >> 4, i = rho & 15; return 8 * (i >> 2) + 4 * n + (i & 3); }

struct Unit { int pm, pn; };
struct Gemm { const bf16_t* A; const bf16_t* Bt; int M, N, K; };

struct StaticOrder {
    int nM, nN, nwg, G, c;
    __host__ __device__ void init(int M, int N, int G_, int c_) { nM = M / BM; nN = N / BM; nwg = nM * nN; G = G_; c = c_; }
    __host__ __device__ bool next(int i, Unit& u) const {
        const long L = (long)i * G + c; if (L >= nwg) return false;
        int wgid = (int)L; { const int q = nwg / NXCD, r = nwg % NXCD, xcd = wgid % NXCD, off = wgid / NXCD; wgid = (xcd < r ? xcd * (q + 1) : r * (q + 1) + (xcd - r) * q) + off; }
        const int nig = WGM * nN, gid = wgid / nig, fm = gid * WGM, gsz = (nM - fm) < WGM ? (nM - fm) : WGM;
        u.pm = fm + ((wgid % nig) % gsz); u.pn = (wgid % nig) / gsz; return true;
    }
    __device__ __forceinline__ void a_ready(const Unit&) const {}
    __device__ __forceinline__ void done(const Unit&) const {}
};

__device__ __forceinline__ unsigned cvt_pk_bf16(float lo, float hi) { unsigned r; asm volatile("v_cvt_pk_bf16_f32 %0, %1, %2" : "=v"(r) : "v"(lo), "v"(hi)); return r; }
__device__ __forceinline__ float fsigmoid(float x) { return __builtin_amdgcn_rcpf(1.0f + __expf(-x)); }
struct EpiBf16 {
    static constexpr bool PERM = true, AFTER_DRAIN = false;
    bf16_t* O; int ldc;
    __device__ __forceinline__ void operator()(const f32x4 (&acc)[2][2][4][2], const Unit& u, int wr, int wc, int fr, int fq) const {
        const int row0 = u.pm * BM + wr * 64 + fr; const int col0 = u.pn * BM + wc * 32 + 8 * fq;
#pragma unroll
        for (int ai = 0; ai < 2; ++ai)
#pragma unroll
            for (int m = 0; m < 4; ++m) { bf16_t* rowp = O + (size_t)(row0 + ai * HALF + m * 16) * ldc + col0;
#pragma unroll
                for (int bj = 0; bj < 2; ++bj) { const f32x4 v0 = acc[ai][bj][m][0], v1 = acc[ai][bj][m][1];
                    u32x4 w; w.x = cvt_pk_bf16(v0[0], v0[1]); w.y = cvt_pk_bf16(v0[2], v0[3]); w.z = cvt_pk_bf16(v1[0], v1[1]); w.w = cvt_pk_bf16(v1[2], v1[3]);
                    *(u32x4*)(rowp + bj * HALF) = w; } }
    }
};
struct EpiSwiglu {
    static constexpr bool PERM = true, AFTER_DRAIN = false;
    bf16_t* O; int ldc;
    __device__ __forceinline__ void operator()(const f32x4 (&acc)[2][2][4][2], const Unit& u, int wr, int wc, int fr, int fq) const {
        const int row0 = u.pm * BM + wr * 64 + fr; const int col0 = u.pn * HALF + wc * 32 + 8 * fq;
#pragma unroll
        for (int ai = 0; ai < 2; ++ai)
#pragma unroll
            for (int m = 0; m < 4; ++m) { bf16_t* rowp = O + (size_t)(row0 + ai * HALF + m * 16) * ldc + col0;
                float h[8];
#pragma unroll
                for (int n = 0; n < 2; ++n)
#pragma unroll
                    for (int e = 0; e < 4; ++e) { const float g = acc[ai][0][m][n][e], up = acc[ai][1][m][n][e]; h[n * 4 + e] = g * fsigmoid(g) * up; }
                u32x4 w; w.x = cvt_pk_bf16(h[0], h[1]); w.y = cvt_pk_bf16(h[2], h[3]); w.z = cvt_pk_bf16(h[4], h[5]); w.w = cvt_pk_bf16(h[6], h[7]);
                *(u32x4*)rowp = w; }
    }
};
struct EpiF32Part {
    static constexpr bool PERM = false, AFTER_DRAIN = false;
    float* Y; int ldc; float* part;
    __device__ __forceinline__ void operator()(const f32x4 (&acc)[2][2][4][2], const Unit& u, int wr, int wc, int fr, int fq) const {
        const int row0 = u.pm * BM + wr * 64 + fr; const int col0 = u.pn * BM + wc * 32 + 4 * fq;
#pragma unroll
        for (int ai = 0; ai < 2; ++ai)
#pragma unroll
            for (int m = 0; m < 4; ++m) { const int row = row0 + ai * HALF + m * 16; float* rowp = Y + (size_t)row * ldc + col0; float ss = 0.f;
#pragma unroll
                for (int bj = 0; bj < 2; ++bj)
#pragma unroll
                    for (int n = 0; n < 2; ++n) { const f32x4 v = acc[ai][bj][m][n]; ss += (v[0] * v[0] + v[1] * v[1]) + (v[2] * v[2] + v[3] * v[3]); *(f32x4*)(rowp + bj * HALF + n * 16) = v; }
                ss += __shfl_xor(ss, 16); ss += __shfl_xor(ss, 32);
                if (fq == 0) part[(size_t)row * 16 + u.pn * 4 + wc] = ss; }
    }
};

template <class Epi, class Sched, bool ALIGN_EPI = false, bool SP2 = false>
__device__ __forceinline__ void gemm_phase(PG8_LAS unsigned char* lds, const Gemm g, const Sched& S, const Epi& E) {
    const int tid = threadIdx.x, wid = __builtin_amdgcn_readfirstlane(tid >> 6), lane = tid & 63, wr = wid >> 2, wc = wid & 3, fr = lane & 15, fq = lane >> 4;
    const int K = g.K, nt = K / BK;
    unsigned voffA[2], voffB[2];
#pragma unroll
    for (int i = 0; i < 2; ++i) { int R, C; stage_rc(tid * 16 + i * 8192, R, C); const int Rb = Epi::PERM ? ((R & ~31) + perm32(R & 31)) : R;
        voffA[i] = (unsigned)(R * K + C) * 2u; voffB[i] = (unsigned)(Rb * K + C) * 2u; }
    const size_t kstep = (size_t)(BK * 2);
    const size_t hstep = (size_t)HALF * K * 2;
    const size_t tstep = 2 * hstep;
    const unsigned ldsw = (unsigned)wid * 1024u;
    const int aoff = lds_byte(wr * 64 + fr, fq * 8), boff = lds_byte(wc * 32 + fr, fq * 8);
#define PG8_SA(b, h) (((b) * 2 + (h)) * HTB)
#define PG8_SB(b, h) ((4 + (b) * 2 + (h)) * HTB)
#define PG8_STAGE(bufoff, gbase, voff) do { _Pragma("unroll") for (int _i = 0; _i < 2; ++_i) \
        __builtin_amdgcn_global_load_lds((const unsigned*)((const char*)(gbase) + (voff)[_i]), (PG8_LAS unsigned*)(lds + (bufoff) + ldsw + _i * 8192), 16, 0, 0); } while (0)
#define PG8_LDA(dst, b, h) do { _Pragma("unroll") for (int m = 0; m < 4; ++m) _Pragma("unroll") for (int k = 0; k < 2; ++k) dst[m][k] = *(const PG8_LAS bf16x8*)(lds + PG8_SA(b, h) + aoff + m * 2048 + k * 1024); } while (0)
#define PG8_LDB(dst, b, h) do { _Pragma("unroll") for (int n = 0; n < 2; ++n) _Pragma("unroll") for (int k = 0; k < 2; ++k) dst[n][k] = *(const PG8_LAS bf16x8*)(lds + PG8_SB(b, h) + boff + n * 2048 + k * 1024); } while (0)
#define PG8_MMA(ai, bj, At, Bt) do { __builtin_amdgcn_s_setprio(1); _Pragma("unroll") for (int m = 0; m < 4; ++m) _Pragma("unroll") for (int n = 0; n < 2; ++n) _Pragma("unroll") for (int k = 0; k < 2; ++k) \
        acc[ai][bj][m][n] = __builtin_amdgcn_mfma_f32_16x16x32_bf16(Bt[n][k], At[m][k], acc[ai][bj][m][n], 0, 0, 0); __builtin_amdgcn_s_setprio(0); } while (0)
#define PG8_WAIT_V(n) asm volatile("s_waitcnt vmcnt(" #n ")" ::: "memory")
#define PG8_WAIT_L(n) asm volatile("s_waitcnt lgkmcnt(" #n ")" ::: "memory")
#define PG8_BAR __builtin_amdgcn_s_barrier()
#define PG8_SCHED __builtin_amdgcn_sched_barrier(0)
    Unit cur, nxt; int ui = 0;
    if (!S.next(0, cur)) return;
    f32x4 acc[2][2][4][2];
#pragma unroll
    for (int a = 0; a < 2; ++a)
#pragma unroll
        for (int b = 0; b < 2; ++b)
#pragma unroll
            for (int m = 0; m < 4; ++m)
#pragma unroll
                for (int n = 0; n < 2; ++n) acc[a][b][m][n] = (f32x4){0.f, 0.f, 0.f, 0.f};
    bf16x8 At[4][2], B0[2][2], B1[2][2];
    const char* cA = (const char*)g.A + (size_t)cur.pm * tstep; const char* cB = (const char*)g.Bt + (size_t)cur.pn * tstep;
    S.a_ready(cur);
    if constexpr (SP2) {
        PG8_STAGE(PG8_SB(0, 0), cB, voffB); PG8_STAGE(PG8_SB(0, 1), cB + hstep, voffB); PG8_STAGE(PG8_SA(0, 0), cA, voffA); PG8_STAGE(PG8_SA(0, 1), cA + hstep, voffA);
        if (wr == 1) PG8_BAR;
        PG8_WAIT_V(2); PG8_BAR;
        PG8_STAGE(PG8_SB(1, 0), cB + kstep, voffB); PG8_STAGE(PG8_SA(1, 0), cA + kstep, voffA); PG8_STAGE(PG8_SB(1, 1), cB + hstep + kstep, voffB);
        PG8_WAIT_V(6); PG8_BAR;
    } else {
        PG8_STAGE(PG8_SB(0, 0), cB, voffB); PG8_STAGE(PG8_SA(0, 0), cA, voffA); PG8_STAGE(PG8_SB(0, 1), cB + hstep, voffB); PG8_STAGE(PG8_SA(0, 1), cA + hstep, voffA);
        if (wr == 1) PG8_BAR;
        PG8_WAIT_V(4); PG8_BAR;
        PG8_STAGE(PG8_SB(1, 0), cB + kstep, voffB); PG8_STAGE(PG8_SA(1, 0), cA + kstep, voffA); PG8_STAGE(PG8_SB(1, 1), cB + hstep + kstep, voffB);
        PG8_WAIT_V(6); PG8_BAR;
    }
    for (;;) {
        const bool has_next = S.next(ui + 1, nxt);
        const char* nA = has_next ? (const char*)g.A + (size_t)nxt.pm * tstep : cA; const char* nB = has_next ? (const char*)g.Bt + (size_t)nxt.pn * tstep : cB;
        for (int t = 0; t < nt; t += 2) {
            const bool last = (t == nt - 2);
            const char* a1 = cA + (size_t)(t + 1) * kstep;
            const char* a2 = last ? nA : cA + (size_t)(t + 2) * kstep; const char* b2 = last ? nB : cB + (size_t)(t + 2) * kstep;
            const char* a3 = a2 + kstep; const char* b3 = b2 + kstep;
            if (last && has_next) S.a_ready(nxt);
            if constexpr (SP2) {
            PG8_LDB(B0, 0, 0); PG8_LDB(B1, 0, 1); PG8_SCHED; PG8_LDA(At, 0, 0); PG8_STAGE(PG8_SA(1, 1), a1 + hstep, voffA);
            PG8_WAIT_V(8); PG8_WAIT_L(0); PG8_BAR; PG8_MMA(0, 0, At, B0); PG8_MMA(0, 1, At, B1); PG8_BAR; PG8_SCHED;
            PG8_LDA(At, 0, 1); PG8_STAGE(PG8_SB(0, 0), b2, voffB); PG8_STAGE(PG8_SB(0, 1), b2 + hstep, voffB); PG8_STAGE(PG8_SA(0, 0), a2, voffA);
            PG8_WAIT_V(8); PG8_WAIT_L(0); PG8_BAR; PG8_MMA(1, 0, At, B0); PG8_MMA(1, 1, At, B1); PG8_BAR; PG8_SCHED;
            PG8_LDB(B0, 1, 0); PG8_LDB(B1, 1, 1); PG8_SCHED; PG8_LDA(At, 1, 0); PG8_STAGE(PG8_SA(0, 1), a2 + hstep, voffA);
            PG8_WAIT_V(8); PG8_WAIT_L(0); PG8_BAR; PG8_MMA(0, 0, At, B0); PG8_MMA(0, 1, At, B1); PG8_BAR; PG8_SCHED;
            PG8_LDA(At, 1, 1); PG8_STAGE(PG8_SB(1, 0), b3, voffB); PG8_STAGE(PG8_SB(1, 1), b3 + hstep, voffB); PG8_STAGE(PG8_SA(1, 0), a3, voffA);
            PG8_WAIT_V(8); PG8_WAIT_L(0); PG8_BAR; PG8_MMA(1, 0, At, B0); PG8_MMA(1, 1, At, B1); PG8_BAR; PG8_SCHED;
            } else {
            PG8_LDB(B0, 0, 0); PG8_SCHED; PG8_LDA(At, 0, 0); PG8_STAGE(PG8_SA(1, 1), a1 + hstep, voffA);
            PG8_WAIT_L(8); PG8_BAR; PG8_WAIT_L(0); PG8_MMA(0, 0, At, B0); PG8_BAR; PG8_SCHED;
            PG8_LDB(B1, 0, 1); PG8_STAGE(PG8_SB(0, 0), b2, voffB);
            PG8_BAR; PG8_WAIT_L(0); PG8_MMA(0, 1, At, B1); PG8_BAR;
            PG8_LDA(At, 0, 1); PG8_STAGE(PG8_SA(0, 0), a2, voffA);
            PG8_BAR; PG8_WAIT_L(0); PG8_MMA(1, 0, At, B0); PG8_BAR; PG8_SCHED;
            PG8_STAGE(PG8_SB(0, 1), b2 + hstep, voffB);
            PG8_WAIT_V(6); PG8_BAR; PG8_MMA(1, 1, At, B1); PG8_BAR;
            PG8_LDB(B0, 1, 0); PG8_SCHED; PG8_LDA(At, 1, 0); PG8_STAGE(PG8_SA(0, 1), a2 + hstep, voffA);
            PG8_WAIT_L(8); PG8_BAR; PG8_WAIT_L(0); PG8_MMA(0, 0, At, B0); PG8_BAR; PG8_SCHED;
            PG8_LDB(B1, 1, 1); PG8_STAGE(PG8_SB(1, 0), b3, voffB);
            PG8_BAR; PG8_WAIT_L(0); PG8_MMA(0, 1, At, B1); PG8_BAR;
            PG8_LDA(At, 1, 1); PG8_STAGE(PG8_SA(1, 0), a3, voffA);
            PG8_BAR; PG8_WAIT_L(0); PG8_MMA(1, 0, At, B0); PG8_BAR; PG8_SCHED;
            PG8_STAGE(PG8_SB(1, 1), b3 + hstep, voffB);
            PG8_WAIT_V(6); PG8_BAR; PG8_MMA(1, 1, At, B1); PG8_BAR;
            }
        }
        if constexpr (ALIGN_EPI) { if (wr == 0) PG8_BAR; }
        if constexpr (!Epi::AFTER_DRAIN) { E(acc, cur, wr, wc, fr, fq); S.done(cur); }
        if (!has_next) break;
#pragma unroll
        for (int a = 0; a < 2; ++a)
#pragma unroll
            for (int b = 0; b < 2; ++b)
#pragma unroll
                for (int m = 0; m < 4; ++m)
#pragma unroll
                    for (int n = 0; n < 2; ++n) acc[a][b][m][n] = (f32x4){0.f, 0.f, 0.f, 0.f};
        cur = nxt; cA = nA; cB = nB; ++ui;
        if constexpr (ALIGN_EPI) { if (wr == 1) PG8_BAR; }
    }
    PG8_WAIT_V(0);
    if constexpr (!ALIGN_EPI) { if (wr == 0) PG8_BAR; }
    PG8_BAR;
    if constexpr (Epi::AFTER_DRAIN) { E.fused(acc, cur, wr, wc, fr, fq, lds, wid, lane); S.done(cur); }
#undef PG8_SA
#undef PG8_SB
#undef PG8_STAGE
#undef PG8_LDA
#undef PG8_LDB
#undef PG8_MMA
#undef PG8_WAIT_V
#undef PG8_WAIT_L
#undef PG8_BAR
#undef PG8_SCHED
}
}
#ifndef PG8_SP2
#define PG8_SP2 true
#endif
#ifndef PG8_ALIGN
#define PG8_ALIGN true
#endif
#ifndef MK_RECURRENT
#define MK_RECURRENT 0
#endif
#ifndef MK_COOP
#define MK_COOP 1
#endif

constexpr int NWAVES = 8, NTHR = NWAVES * 64;
constexpr int BATCH = 4, SEQ = 4096, M = BATCH * SEQ, D = 1024, FF = 2816, NMI = 3584, LDMI = 3592;
constexpr float EPS = 1e-6f;
constexpr int NPHASE = 13;
constexpr size_t KiB = 1024, MiB = 1u << 20;
constexpr size_t WS_PART = 0, WS_GATES = 1 * MiB, WS_DEC = 1 * MiB + 512 * KiB;
constexpr size_t WS_W1I = 3 * MiB, WS_W1O = 14 * MiB, WS_WMI = 19 * MiB + 512 * KiB, WS_WMO = 26 * MiB + 512 * KiB, WS_W2I = 28 * MiB + 512 * KiB, WS_W2O = 39 * MiB + 512 * KiB;
constexpr size_t WS_XN = 45 * MiB;
constexpr size_t WS_ACT = 77 * MiB, WS_Y = 165 * MiB;
constexpr size_t WS_P = 77 * MiB, WS_S = 189 * MiB;
constexpr size_t WS_END = 239 * MiB;
constexpr int LDS_BYTES = 147456;

typedef unsigned short bf16;
typedef float f32x4 __attribute__((ext_vector_type(4)));
typedef unsigned u32x4 __attribute__((ext_vector_type(4)));
typedef unsigned u32x2 __attribute__((ext_vector_type(2)));
#define LAS __attribute__((address_space(3)))

__device__ __forceinline__ float wave_sum(float v) {
#pragma unroll
    for (int o = 1; o < 64; o <<= 1) v += __shfl_xor(v, o);
    return v;
}
typedef __bf16 bf16v2 __attribute__((ext_vector_type(2)));
typedef float f32v2 __attribute__((ext_vector_type(2)));
__device__ __forceinline__ unsigned pk2(float lo, float hi) { const f32v2 v = {lo, hi}; const bf16v2 b = __builtin_convertvector(v, bf16v2); return __builtin_bit_cast(unsigned, b); }
__device__ __forceinline__ void unpack8(const u32x4 w, float (&f)[8]) {
    f[0] = __uint_as_float(w.x << 16); f[1] = __uint_as_float(w.x & 0xffff0000u); f[2] = __uint_as_float(w.y << 16); f[3] = __uint_as_float(w.y & 0xffff0000u);
    f[4] = __uint_as_float(w.z << 16); f[5] = __uint_as_float(w.z & 0xffff0000u); f[6] = __uint_as_float(w.w << 16); f[7] = __uint_as_float(w.w & 0xffff0000u);
}
__device__ __forceinline__ float sigm(float x) { return 1.0f / (1.0f + __expf(-x)); }

template <int MODE>
__device__ __forceinline__ void transpose_item(const float* W, int K, int ldw, int ncols, bf16* WT, float* scr, int item, int lane) {
    const int nblk = ncols / 32, kb = item / nblk, nb = item % nblk, k0 = 64 * kb, n0 = 32 * nb;
#pragma unroll 8
    for (int i = 0; i < 32; ++i) { const int kk = 2 * i + (lane >> 5); scr[kk * 33 + (lane & 31)] = W[(size_t)(k0 + kk) * ldw + n0 + (lane & 31)]; }
    asm volatile("s_waitcnt lgkmcnt(0)" ::: "memory");
    int d0 = n0;
    if (MODE == 1) { if (n0 < FF) d0 = 256 * (n0 / 128) + (n0 % 128); else { const int jj = n0 - FF; d0 = 256 * (jj / 128) + 128 + (jj % 128); } }
    const int c = lane & 7;
#pragma unroll
    for (int j = 0; j < 4; ++j) { const int n = (lane >> 3) + 8 * j; const float* s = scr + (8 * c) * 33 + n;
        u32x4 o; o.x = pk2(s[0 * 33], s[1 * 33]); o.y = pk2(s[2 * 33], s[3 * 33]); o.z = pk2(s[4 * 33], s[5 * 33]); o.w = pk2(s[6 * 33], s[7 * 33]);
        *(u32x4*)(WT + (size_t)(d0 + n) * K + k0 + 8 * c) = o; }
    asm volatile("s_waitcnt lgkmcnt(0)" ::: "memory");
}

__device__ __forceinline__ void norm_rows(int gw, int NGW, int lane, const float* xres, const float* y, const float* part, float alpha, const float* g_post,
                                          float* xout, const float* g_pre, bf16* hn, const float* w8, const float* gate_bias, float* gates_out) {
    for (int m = gw; m < M; m += NGW) {
        f32x4 v[4];
        const f32x4* xr = (const f32x4*)(xres + (size_t)m * D) + lane;
#pragma unroll
        for (int j = 0; j < 4; ++j) v[j] = xr[64 * j];
        if (y) {
            float ps = part[(size_t)m * 16 + (lane & 15)];
            ps += __shfl_xor(ps, 1); ps += __shfl_xor(ps, 2); ps += __shfl_xor(ps, 4); ps += __shfl_xor(ps, 8);
            const float rs = rsqrtf(ps * (1.0f / D) + EPS) * alpha;
            const f32x4* yr = (const f32x4*)(y + (size_t)m * D) + lane; const f32x4* gp = (const f32x4*)g_post + lane;
#pragma unroll
            for (int j = 0; j < 4; ++j) { const f32x4 yy = yr[64 * j], gg = gp[64 * j]; v[j] = v[j] + yy * gg * rs; }
        }
        if (xout) { f32x4* xo = (f32x4*)(xout + (size_t)m * D) + lane;
#pragma unroll
            for (int j = 0; j < 4; ++j) xo[64 * j] = v[j]; }
        if (hn) {
            float s2 = 0.f;
#pragma unroll
            for (int j = 0; j < 4; ++j) s2 += (v[j].x * v[j].x + v[j].y * v[j].y) + (v[j].z * v[j].z + v[j].w * v[j].w);
            s2 = wave_sum(s2);
            const float r = rsqrtf(s2 * (1.0f / D) + EPS);
            const f32x4* gq = (const f32x4*)g_pre + lane;
            u32x2* o8 = (u32x2*)(hn + (size_t)m * D) + lane;
#pragma unroll
            for (int j = 0; j < 4; ++j) { const f32x4 gg = gq[64 * j]; v[j] = v[j] * gg * r; u32x2 w; w.x = pk2(v[j].x, v[j].y); w.y = pk2(v[j].z, v[j].w); o8[64 * j] = w; }
            if (gates_out) {
                float d[8];
#pragma unroll
                for (int c = 0; c < 8; ++c) d[c] = 0.f;
#pragma unroll
                for (int j = 0; j < 4; ++j)
#pragma unroll
                    for (int e = 0; e < 4; ++e) { const int k = 4 * (64 * j + lane) + e; const f32x4 wa = *(const f32x4*)(w8 + k * 8), wb = *(const f32x4*)(w8 + k * 8 + 4); const float hv = v[j][e];
                        d[0] += hv * wa.x; d[1] += hv * wa.y; d[2] += hv * wa.z; d[3] += hv * wa.w; d[4] += hv * wb.x; d[5] += hv * wb.y; d[6] += hv * wb.z; d[7] += hv * wb.w; }
#pragma unroll
                for (int c = 0; c < 8; ++c) d[c] = wave_sum(d[c]);
                float o = d[0];
#pragma unroll
                for (int c = 1; c < 8; ++c) o = (lane == c) ? d[c] : o;
                if (lane < 8) gates_out[(size_t)m * 8 + lane] = o + gate_bias[lane];
            }
        }
    }
}

struct MixArgs { const bf16* P; const float* gates; const float* lbl; const float* conv_w; const float* conv_b; const float* hg_norm; const float* ml_norm; bf16* mix; };
template <int TY, bool NEEDQ>
__device__ __forceinline__ void load_qkf(const MixArgs& A, int b, int h, int tl, int o, float (&q)[8], float (&kk)[8], float (&lf)[8]) {
    const size_t row = (size_t)b * SEQ + tl;
    if (TY == 0) {
        const int col = h * 128 + 8 * o;
        float hq[8], hf[8];
        unpack8(*(const u32x4*)(A.P + row * NMI + col), hq); unpack8(*(const u32x4*)(A.P + row * NMI + 512 + col), hf);
#pragma unroll
        for (int e = 0; e < 8; ++e) {
            const float lbv = sigm(A.lbl[col + e] - A.lbl[512 + col + e]);
            q[e] = hq[e] * sigm(hq[e]);
            const float f = lbv + (1.0f - lbv) * sigm(hf[e]);
            kk[e] = (1.0f - lbv) * sigm(-hf[e]);
            lf[e] = __logf(f);
        }
    } else {
        const int col = h * 64 + 8 * o;
        float aq[8], ak[8];
#pragma unroll
        for (int e = 0; e < 8; ++e) { aq[e] = A.conv_b[col + e]; ak[e] = A.conv_b[256 + col + e]; }
#pragma unroll
        for (int j = 0; j < 4; ++j) {
            const int tt = tl - 3 + j;
            if (tt >= 0) {
                float xq[8], xk[8];
                const size_t r2 = (size_t)b * SEQ + tt;
                if (NEEDQ) unpack8(*(const u32x4*)(A.P + r2 * NMI + 2048 + col), xq); else { for (int e = 0; e < 8; ++e) xq[e] = 0.f; } unpack8(*(const u32x4*)(A.P + r2 * NMI + 2304 + col), xk);
#pragma unroll
                for (int e = 0; e < 8; ++e) { aq[e] += A.conv_w[j * 512 + col + e] * xq[e]; ak[e] += A.conv_w[j * 512 + 256 + col + e] * xk[e]; }
            }
        }
        const float li = A.gates[row * 8 + h], fg = A.gates[row * 8 + 4 + h];
        const float ei = __expf(li);
        const float lfv = fminf(fg, 0.f) - log1pf(__expf(-fabsf(fg)));
#pragma unroll
        for (int e = 0; e < 8; ++e) { q[e] = aq[e] * sigm(aq[e]) * 0.125f; kk[e] = ak[e] * sigm(ak[e]) * ei; lf[e] = lfv; }
    }
}
template <int TY>
__device__ __forceinline__ void mix_epilogue(const float* OO, const float* DEN, int R, const MixArgs& A, int b, int h, int t0, int tid) {
    for (int idx = tid; idx < R * 16; idx += NTHR) {
        const int row = idx >> 4, part = idx & 15;
        float o[8];
        { const f32x4 a = *(const f32x4*)(OO + row * 128 + part * 8), c = *(const f32x4*)(OO + row * 128 + part * 8 + 4); o[0] = a.x; o[1] = a.y; o[2] = a.z; o[3] = a.w; o[4] = c.x; o[5] = c.y; o[6] = c.z; o[7] = c.w; }
        float sc = 1.0f;
        if (TY == 1) sc = 1.0f / fmaxf(fabsf(DEN[row]), 1.0f);
        float ss = 0.f;
#pragma unroll
        for (int e = 0; e < 8; ++e) { o[e] *= sc; ss += o[e] * o[e]; }
        ss += __shfl_xor(ss, 1); ss += __shfl_xor(ss, 2); ss += __shfl_xor(ss, 4); ss += __shfl_xor(ss, 8);
        const float r = rsqrtf(ss * (1.0f / 128.0f) + EPS);
        const size_t grow = (size_t)b * SEQ + t0 + row;
        float g[8];
        unpack8(*(const u32x4*)(A.P + grow * NMI + (TY == 0 ? 1536 : 3072) + h * 128 + part * 8), g);
        const float* nw = (TY == 0 ? A.hg_norm : A.ml_norm) + h * 128 + part * 8;
#pragma unroll
        for (int e = 0; e < 8; ++e) { const float gv = (TY == 0) ? g[e] * sigm(g[e]) : sigm(g[e]); o[e] = o[e] * r * nw[e] * gv; }
        u32x4 w; w.x = pk2(o[0], o[1]); w.y = pk2(o[2], o[3]); w.z = pk2(o[4], o[5]); w.w = pk2(o[6], o[7]);
        *(u32x4*)(A.mix + grow * D + TY * 512 + h * 128 + part * 8) = w;
    }
}
template <int TY>
__device__ __forceinline__ void mixer_recurrent(float* ldsf, const MixArgs& A, int b, int h, int tid) {
    constexpr int DK = TY == 0 ? 128 : 64, KPT = DK / 4, OCT = DK / 8, R = 32;
    float* QQ = ldsf; float* KK = QQ + R * DK; float* FFt = KK + R * DK; float* VV = FFt + R * DK; float* OO = VV + R * 128; float* DEN = OO + R * 128;
    const int lane = tid & 63, wave = tid >> 6, v = wave * 16 + (lane & 15), kg = lane >> 4;
    float S[KPT], N[KPT];
#pragma unroll
    for (int i = 0; i < KPT; ++i) { S[i] = 0.f; N[i] = 0.f; }
    for (int sc = 0; sc < SEQ / R; ++sc) {
        const int t0 = sc * R;
        for (int idx = tid; idx < R * OCT; idx += NTHR) {
            const int row = idx / OCT, o = idx % OCT; float q[8], kk[8], lf[8];
            load_qkf<TY, true>(A, b, h, t0 + row, o, q, kk, lf);
#pragma unroll
            for (int e = 0; e < 8; ++e) { QQ[row * DK + 8 * o + e] = q[e]; KK[row * DK + 8 * o + e] = kk[e]; FFt[row * DK + 8 * o + e] = __expf(lf[e]); }
        }
        { const int row = tid >> 4, o = tid & 15; float vv[8];
          unpack8(*(const u32x4*)(A.P + ((size_t)b * SEQ + t0 + row) * NMI + (TY == 0 ? 1024 : 2560) + h * 128 + 8 * o), vv);
#pragma unroll
          for (int e = 0; e < 8; ++e) VV[row * 128 + 8 * o + e] = vv[e]; }
        __syncthreads();
        for (int s = 0; s < R; ++s) {
            const float vv = VV[s * 128 + v]; float o = 0.f, dn = 0.f;
#pragma unroll
            for (int i = 0; i < KPT; ++i) { const int k = kg * KPT + i; const float f = FFt[s * DK + k], kx = KK[s * DK + k], qx = QQ[s * DK + k];
                S[i] = f * S[i] + kx * vv; o += qx * S[i];
                if (TY == 1) { N[i] = f * N[i] + kx; dn += qx * N[i]; } }
            o += __shfl_xor(o, 16); o += __shfl_xor(o, 32);
            if (kg == 0) OO[s * 128 + v] = o;
            if (TY == 1) { dn += __shfl_xor(dn, 16); dn += __shfl_xor(dn, 32); if (tid == 0) DEN[s] = dn; }
        }
        __syncthreads();
        mix_epilogue<TY>(OO, DEN, R, A, b, h, t0, tid);
        __syncthreads();
    }
}


template <int TY> struct MixCfg { static constexpr int DK = TY == 0 ? 128 : 64, DKP = DK + 8, DVT = TY == 0 ? 8 : 9, OCT = DK / 8, KS = DK / 32; };
constexpr int VTP = 72;
constexpr int ML_G = 0, ML_K = 32768, ML_QSZ = 17408, ML_VT = ML_K + 3 * ML_QSZ, ML_KT = ML_VT + 144 * VTP * 2, ML_MISC = ML_KT + 128 * VTP * 2;
static_assert(ML_MISC + 256 + 2048 <= LDS_BYTES, "mixer LDS map");
typedef short bf16x8v __attribute__((ext_vector_type(8)));
__device__ __forceinline__ unsigned short f2bf1(float f) { return (unsigned short)(pk2(f, 0.f) & 0xffffu); }

template <int TY>
__device__ __forceinline__ void load_vt(bf16* VT, const MixArgs& A, int b, int h, int t0, int tid) {
    for (int idx = tid; idx < 64 * 16; idx += NTHR) {
        const int row = idx & 63, o = idx >> 6;
        const u32x4 w = *(const u32x4*)(A.P + ((size_t)b * SEQ + t0 + row) * NMI + (TY == 0 ? 1024 : 2560) + h * 128 + 8 * o);
        bf16* d = VT + (8 * o) * VTP + row;
        d[0 * VTP] = (bf16)(w.x & 0xffffu); d[1 * VTP] = (bf16)(w.x >> 16); d[2 * VTP] = (bf16)(w.y & 0xffffu); d[3 * VTP] = (bf16)(w.y >> 16);
        d[4 * VTP] = (bf16)(w.z & 0xffffu); d[5 * VTP] = (bf16)(w.z >> 16); d[6 * VTP] = (bf16)(w.w & 0xffffu); d[7 * VTP] = (bf16)(w.w >> 16);
    }
    if (TY == 1) for (int idx = tid; idx < 16 * 64; idx += NTHR) { const int vv = idx >> 6, s = idx & 63; VT[(128 + vv) * VTP + s] = (vv == 0) ? (bf16)0x3F80u : (bf16)0u; }
}
template <int DK>
__device__ __forceinline__ void cumsum64(float* G, float* SEGS, int tid) {
    constexpr int SEG = NTHR / DK, RPS = 64 / SEG;
    const int k = tid % DK, sg = tid / DK;
    float v[RPS]; float acc = 0.f;
#pragma unroll
    for (int i = 0; i < RPS; ++i) { acc += G[(sg * RPS + i) * DK + k]; v[i] = acc; }
    SEGS[sg * DK + k] = acc;
    __syncthreads();
    float off = 0.f;
#pragma unroll
    for (int s2 = 0; s2 < SEG; ++s2) if (s2 < sg) off += SEGS[s2 * DK + k];
#pragma unroll
    for (int i = 0; i < RPS; ++i) G[(sg * RPS + i) * DK + k] = v[i] + off;
}
template <int TY>
__device__ __forceinline__ void mixer_passA(unsigned char* lds, const MixArgs& A, bf16* Sbuf, float* DECbuf, int item, int tid) {
    typedef MixCfg<TY> C; constexpr int DK = C::DK, OCT = C::OCT, DVT = C::DVT, KTN = DK / 16;
    float* G = (float*)(lds + ML_G); float* KKf = (float*)(lds + ML_K); bf16* VT = (bf16*)(lds + ML_VT); bf16* KT = (bf16*)(lds + ML_KT); float* SEGS = (float*)(lds + ML_MISC + 256);
    const int b = item >> 8, h = (item >> 6) & 3, c = item & 63, t0 = c * 64;
    bf16* Sout = Sbuf + (TY == 0 ? (size_t)item * 16384 : (size_t)1024 * 16384 + (size_t)item * 9216);
    float* DEC = DECbuf + (TY == 0 ? item * 128 : 1024 * 128 + item * 64);
    for (int idx = tid; idx < 64 * OCT; idx += NTHR) {
        const int row = idx / OCT, o = idx % OCT; float q[8], kk[8], lf[8];
        load_qkf<TY, false>(A, b, h, t0 + row, o, q, kk, lf);
        *(f32x4*)(G + row * DK + 8 * o) = (f32x4){lf[0], lf[1], lf[2], lf[3]}; *(f32x4*)(G + row * DK + 8 * o + 4) = (f32x4){lf[4], lf[5], lf[6], lf[7]};
        *(f32x4*)(KKf + row * DK + 8 * o) = (f32x4){kk[0], kk[1], kk[2], kk[3]}; *(f32x4*)(KKf + row * DK + 8 * o + 4) = (f32x4){kk[4], kk[5], kk[6], kk[7]};
    }
    load_vt<TY>(VT, A, b, h, t0, tid);
    __syncthreads();
    cumsum64<DK>(G, SEGS, tid);
    __syncthreads();
    for (int idx = tid; idx < DK * 8; idx += NTHR) {
        const int k = idx % DK, so = idx / DK; const float ge = G[63 * DK + k]; float kv[8];
#pragma unroll
        for (int e = 0; e < 8; ++e) { const int s = 8 * so + e; kv[e] = KKf[s * DK + k] * __expf(ge - G[s * DK + k]); }
        u32x4 w; w.x = pk2(kv[0], kv[1]); w.y = pk2(kv[2], kv[3]); w.z = pk2(kv[4], kv[5]); w.w = pk2(kv[6], kv[7]);
        *(u32x4*)(KT + k * VTP + 8 * so) = w;
        if (so == 0) DEC[k] = __expf(ge);
    }
    __syncthreads();
    const int lane = tid & 63, wave = tid >> 6, r = lane & 15, q4 = lane >> 4;
    for (int tile = wave; tile < DVT * KTN; tile += NWAVES) {
        const int vt = tile / KTN, kt = tile % KTN;
        f32x4 acc = (f32x4){0.f, 0.f, 0.f, 0.f};
#pragma unroll
        for (int ks = 0; ks < 2; ++ks) { const bf16x8v a = *(const bf16x8v*)(VT + (16 * vt + r) * VTP + 32 * ks + 8 * q4), bb = *(const bf16x8v*)(KT + (16 * kt + r) * VTP + 32 * ks + 8 * q4);
            acc = __builtin_amdgcn_mfma_f32_16x16x32_bf16(a, bb, acc, 0, 0, 0); }
#pragma unroll
        for (int i = 0; i < 4; ++i) Sout[(16 * vt + 4 * q4 + i) * DK + 16 * kt + r] = f2bf1(acc[i]);
    }
    __syncthreads();
}
__device__ __forceinline__ void mixer_scan(bf16* Sbuf, const float* DECbuf, int gtid, int gthreads) {
    constexpr int NC0 = 16 * 128 * 32, NC1 = 16 * 144 * 16;
    for (int j = gtid; j < NC0 + NC1; j += gthreads) {
        size_t base; int dbase, sstride, dstride;
        if (j < NC0) { const int bh = j >> 12, rem = j & 4095, v = rem >> 5, kq = rem & 31; base = ((size_t)(bh * 64) * 128 + v) * 128 + 4 * kq; sstride = 16384; dbase = bh * 64 * 128 + 4 * kq; dstride = 128; }
        else { const int j2 = j - NC0, bh = j2 / 2304, rem = j2 % 2304, v = rem >> 4, kq = rem & 15; base = (size_t)1024 * 16384 + ((size_t)(bh * 64) * 144 + v) * 64 + 4 * kq; sstride = 9216; dbase = 1024 * 128 + bh * 64 * 64 + 4 * kq; dstride = 64; }
        f32x4 s = (f32x4){0.f, 0.f, 0.f, 0.f};
        for (int c0 = 0; c0 < 64; c0 += 8) {
            u32x2 w[8]; f32x4 d[8];
#pragma unroll
            for (int i = 0; i < 8; ++i) { w[i] = *(const u32x2*)(Sbuf + base + (size_t)(c0 + i) * sstride); d[i] = *(const f32x4*)(DECbuf + dbase + (c0 + i) * dstride); }
#pragma unroll
            for (int i = 0; i < 8; ++i) {
                u32x2 o; o.x = pk2(s.x, s.y); o.y = pk2(s.z, s.w);
                *(u32x2*)(Sbuf + base + (size_t)(c0 + i) * sstride) = o;
                const f32x4 l = (f32x4){__uint_as_float(w[i].x << 16), __uint_as_float(w[i].x & 0xffff0000u), __uint_as_float(w[i].y << 16), __uint_as_float(w[i].y & 0xffff0000u)};
                s = d[i] * s + l;
            }
        }
    }
}
template <int TY>
__device__ __forceinline__ void mixer_passC(unsigned char* lds, const MixArgs& A, const bf16* Sbuf, int item, int tid) {
    typedef MixCfg<TY> C; constexpr int DK = C::DK, DKP = C::DKP, OCT = C::OCT, DVT = C::DVT, KS = C::KS;
    float* G = (float*)(lds + ML_G); float* OO = G; bf16* QH = (bf16*)(lds + ML_K); bf16* QT = (bf16*)(lds + ML_K + ML_QSZ); bf16* KH = (bf16*)(lds + ML_K + 2 * ML_QSZ);
    bf16* VT = (bf16*)(lds + ML_VT); float* DEN = (float*)(lds + ML_MISC); float* SEGS = (float*)(lds + ML_MISC + 256);
    const int b = item >> 8, h = (item >> 6) & 3, c = item & 63, t0 = c * 64;
    const bf16* Sg = Sbuf + (TY == 0 ? (size_t)item * 16384 : (size_t)1024 * 16384 + (size_t)item * 9216);
    for (int idx = tid; idx < 64 * OCT; idx += NTHR) {
        const int row = idx / OCT, o = idx % OCT; float q[8], kk[8], lf[8];
        load_qkf<TY, true>(A, b, h, t0 + row, o, q, kk, lf);
        *(f32x4*)(G + row * DK + 8 * o) = (f32x4){lf[0], lf[1], lf[2], lf[3]}; *(f32x4*)(G + row * DK + 8 * o + 4) = (f32x4){lf[4], lf[5], lf[6], lf[7]};
        u32x4 w; w.x = pk2(q[0], q[1]); w.y = pk2(q[2], q[3]); w.z = pk2(q[4], q[5]); w.w = pk2(q[6], q[7]); *(u32x4*)(QH + row * DKP + 8 * o) = w;
        w.x = pk2(kk[0], kk[1]); w.y = pk2(kk[2], kk[3]); w.z = pk2(kk[4], kk[5]); w.w = pk2(kk[6], kk[7]); *(u32x4*)(KH + row * DKP + 8 * o) = w;
    }
    load_vt<TY>(VT, A, b, h, t0, tid);
    __syncthreads();
    cumsum64<DK>(G, SEGS, tid);
    __syncthreads();
    for (int idx = tid; idx < 64 * OCT; idx += NTHR) {
        const int row = idx / OCT, o = idx % OCT; float q[8], kk[8], qh[8], kh[8], qt[8];
        unpack8(*(const u32x4*)(QH + row * DKP + 8 * o), q); unpack8(*(const u32x4*)(KH + row * DKP + 8 * o), kk);
#pragma unroll
        for (int e = 0; e < 8; ++e) { const int k = 8 * o + e; const float g = G[row * DK + k], d = g - G[31 * DK + k];
            qh[e] = q[e] * __expf(fminf(d, 80.f)); kh[e] = kk[e] * __expf(fminf(-d, 80.f)); qt[e] = q[e] * __expf(g); }
        u32x4 w; w.x = pk2(qh[0], qh[1]); w.y = pk2(qh[2], qh[3]); w.z = pk2(qh[4], qh[5]); w.w = pk2(qh[6], qh[7]); *(u32x4*)(QH + row * DKP + 8 * o) = w;
        w.x = pk2(kh[0], kh[1]); w.y = pk2(kh[2], kh[3]); w.z = pk2(kh[4], kh[5]); w.w = pk2(kh[6], kh[7]); *(u32x4*)(KH + row * DKP + 8 * o) = w;
        w.x = pk2(qt[0], qt[1]); w.y = pk2(qt[2], qt[3]); w.z = pk2(qt[4], qt[5]); w.w = pk2(qt[6], qt[7]); *(u32x4*)(QT + row * DKP + 8 * o) = w;
    }
    __syncthreads();
    {
        const int lane = tid & 63, wave = tid >> 6, r = lane & 15, q4 = lane >> 4, jt = wave & 3, half = wave >> 2;
        bf16x8v bqh[KS], bqt[KS];
#pragma unroll
        for (int ks = 0; ks < KS; ++ks) { bqh[ks] = *(const bf16x8v*)(QH + (16 * jt + r) * DKP + 32 * ks + 8 * q4); bqt[ks] = *(const bf16x8v*)(QT + (16 * jt + r) * DKP + 32 * ks + 8 * q4); }
        f32x4 pt[4];
#pragma unroll
        for (int js = 0; js < 4; ++js) {
            pt[js] = (f32x4){0.f, 0.f, 0.f, 0.f};
            if (js <= jt) {
#pragma unroll
                for (int ks = 0; ks < KS; ++ks) { const bf16x8v a = *(const bf16x8v*)(KH + (16 * js + r) * DKP + 32 * ks + 8 * q4); pt[js] = __builtin_amdgcn_mfma_f32_16x16x32_bf16(a, bqh[ks], pt[js], 0, 0, 0); }
                if (js == jt) {
#pragma unroll
                    for (int i = 0; i < 4; ++i) if (4 * q4 + i > r) pt[js][i] = 0.f;
                }
            }
        }
        bf16x8v pb[2];
#pragma unroll
        for (int k2 = 0; k2 < 2; ++k2) { u32x4 w; w.x = pk2(pt[2 * k2][0], pt[2 * k2][1]); w.y = pk2(pt[2 * k2][2], pt[2 * k2][3]); w.z = pk2(pt[2 * k2 + 1][0], pt[2 * k2 + 1][1]); w.w = pk2(pt[2 * k2 + 1][2], pt[2 * k2 + 1][3]);
            pb[k2] = __builtin_bit_cast(bf16x8v, w); }
#pragma unroll
        for (int iv = 0; iv < 5; ++iv) {
            const int vt = half + 2 * iv;
            if (vt < DVT) {
                f32x4 acc = (f32x4){0.f, 0.f, 0.f, 0.f};
#pragma unroll
                for (int ks = 0; ks < KS; ++ks) { const bf16x8v a = *(const bf16x8v*)(Sg + (16 * vt + r) * DK + 32 * ks + 8 * q4); acc = __builtin_amdgcn_mfma_f32_16x16x32_bf16(a, bqt[ks], acc, 0, 0, 0); }
#pragma unroll
                for (int k2 = 0; k2 < 2; ++k2) if (2 * k2 <= jt) {
                    u32x4 w; const u32x2 lo = *(const u32x2*)(VT + (16 * vt + r) * VTP + 32 * k2 + 4 * q4), hi2 = *(const u32x2*)(VT + (16 * vt + r) * VTP + 32 * k2 + 16 + 4 * q4);
                    w.x = lo.x; w.y = lo.y; w.z = hi2.x; w.w = hi2.y;
                    acc = __builtin_amdgcn_mfma_f32_16x16x32_bf16(__builtin_bit_cast(bf16x8v, w), pb[k2], acc, 0, 0, 0); }
                if (vt < 8) *(f32x4*)(OO + (16 * jt + r) * 128 + 16 * vt + 4 * q4) = acc;
                else if (q4 == 0) DEN[16 * jt + r] = acc[0];
            }
        }
    }
    __syncthreads();
    mix_epilogue<TY>(OO, DEN, 64, A, b, h, t0, tid);
    __syncthreads();
}

struct Args { const float* in[15]; float* out; unsigned char* ws; int ph_lo, ph_hi; };
__global__ void __launch_bounds__(NTHR, 2) fwd(Args args) {
    extern __shared__ __attribute__((aligned(16))) unsigned char lds[];
    cg::grid_group grid = cg::this_grid();
    const int tid = threadIdx.x, lane = tid & 63, wave = __builtin_amdgcn_readfirstlane(tid >> 6);
    const int G = gridDim.x, bx = blockIdx.x;
    const int gw = bx * NWAVES + wave, NGW = G * NWAVES;
    unsigned char* ws = args.ws;
    const float* x = args.in[0]; const float* norm_pre = args.in[1]; const float* norm_post = args.in[2];
    float* out = args.out;
    bf16* W1I = (bf16*)(ws + WS_W1I); bf16* W1O = (bf16*)(ws + WS_W1O); bf16* WMI = (bf16*)(ws + WS_WMI); bf16* WMO = (bf16*)(ws + WS_WMO); bf16* W2I = (bf16*)(ws + WS_W2I); bf16* W2O = (bf16*)(ws + WS_W2O);
    bf16* XN = (bf16*)(ws + WS_XN); bf16* ACT = (bf16*)(ws + WS_ACT); float* Y = (float*)(ws + WS_Y); bf16* P = (bf16*)(ws + WS_P);
    float* PART = (float*)(ws + WS_PART); float* GATES = (float*)(ws + WS_GATES);
    LAS unsigned char* ldsl = (LAS unsigned char*)lds;
    const int lo = args.ph_lo, hi = args.ph_hi;
#define IN(k) (lo <= (k) && (k) < hi)
#define SEAM(k) do { if (IN(k) && IN((k) + 1)) grid.sync(); } while (0)

    if (IN(0)) {
        float* scr = (float*)(lds + wave * 16384);
        constexpr int I_FI = (D / 64) * (2 * FF / 32), I_FO = (FF / 64) * (D / 32), I_MI = (D / 64) * (NMI / 32), I_MO = (D / 64) * (D / 32);
        constexpr int NITEMS = 2 * I_FI + 2 * I_FO + I_MI + I_MO;
        for (int it = gw; it < NITEMS; it += NGW) {
            int r = it;
            if (r < I_FI) { transpose_item<1>(args.in[3], D, 2 * FF, 2 * FF, W1I, scr, r, lane); continue; } r -= I_FI;
            if (r < I_FI) { transpose_item<1>(args.in[13], D, 2 * FF, 2 * FF, W2I, scr, r, lane); continue; } r -= I_FI;
            if (r < I_FO) { transpose_item<0>(args.in[4], FF, D, D, W1O, scr, r, lane); continue; } r -= I_FO;
            if (r < I_FO) { transpose_item<0>(args.in[14], FF, D, D, W2O, scr, r, lane); continue; } r -= I_FO;
            if (r < I_MI) { transpose_item<0>(args.in[5], D, LDMI, NMI, WMI, scr, r, lane); continue; } r -= I_MI;
            transpose_item<0>(args.in[12], D, D, D, WMO, scr, r, lane);
        }
        norm_rows(gw, NGW, lane, x, nullptr, nullptr, 0.f, nullptr, nullptr, norm_pre, XN, nullptr, nullptr, nullptr);
    }
    SEAM(0);
    if (IN(1)) {
        pg8::Gemm g{XN, W1I, M, 2 * FF, D}; pg8::StaticOrder S; S.init(M, 2 * FF, G, bx);
        pg8::EpiSwiglu E{ACT, FF};
        pg8::gemm_phase<pg8::EpiSwiglu, pg8::StaticOrder, PG8_ALIGN, PG8_SP2>(ldsl, g, S, E);
    }
    SEAM(1);
    if (IN(2)) {
        pg8::Gemm g{ACT, W1O, M, D, FF}; pg8::StaticOrder S; S.init(M, D, G, bx);
        pg8::EpiF32Part E{Y, D, PART};
        pg8::gemm_phase<pg8::EpiF32Part, pg8::StaticOrder, PG8_ALIGN, PG8_SP2>(ldsl, g, S, E);
    }
    SEAM(2);
    if (IN(3)) {
        float* w8 = (float*)lds;
        for (int i = tid; i < D * 8; i += NTHR) w8[i] = args.in[5][(size_t)(i >> 3) * LDMI + NMI + (i & 7)];
        __syncthreads();
        norm_rows(gw, NGW, lane, x, Y, PART, 0.5f, norm_post, out, norm_pre + D, XN, w8, args.in[8], GATES);
        __syncthreads();
    }
    SEAM(3);
    if (IN(4)) {
        pg8::Gemm g{XN, WMI, M, NMI, D}; pg8::StaticOrder S; S.init(M, NMI, G, bx);
        pg8::EpiBf16 E{P, NMI};
        pg8::gemm_phase<pg8::EpiBf16, pg8::StaticOrder, PG8_ALIGN, PG8_SP2>(ldsl, g, S, E);
    }
    SEAM(4);
    const MixArgs MA{P, GATES, args.in[9], args.in[6], args.in[7], args.in[10], args.in[11], XN};
    bf16* SB = (bf16*)(ws + WS_S); float* DECB = (float*)(ws + WS_DEC);
#if MK_RECURRENT
    if (IN(5)) {
        if (bx < 32) { const int ty = bx >> 4, b = (bx >> 2) & 3, h = bx & 3;
            if (ty == 0) mixer_recurrent<0>((float*)lds, MA, b, h, tid); else mixer_recurrent<1>((float*)lds, MA, b, h, tid); }
    }
#else
    if (IN(5)) { for (int it = bx; it < 2048; it += G) { if (it < 1024) mixer_passA<0>(lds, MA, SB, DECB, it, tid); else mixer_passA<1>(lds, MA, SB, DECB, it - 1024, tid); } }
#endif
    SEAM(5);
#if !MK_RECURRENT
    if (IN(6)) mixer_scan(SB, DECB, bx * NTHR + tid, G * NTHR);
#endif
    SEAM(6);
#if !MK_RECURRENT
    if (IN(7)) { for (int it = bx; it < 2048; it += G) { if (it < 1024) mixer_passC<0>(lds, MA, SB, it, tid); else mixer_passC<1>(lds, MA, SB, it - 1024, tid); } }
#endif
    SEAM(7);
    if (IN(8)) {
        pg8::Gemm g{XN, WMO, M, D, D}; pg8::StaticOrder S; S.init(M, D, G, bx);
        pg8::EpiF32Part E{Y, D, PART};
        pg8::gemm_phase<pg8::EpiF32Part, pg8::StaticOrder, PG8_ALIGN, PG8_SP2>(ldsl, g, S, E);
    }
    SEAM(8);
    if (IN(9)) norm_rows(gw, NGW, lane, out, Y, PART, 1.0f, norm_post + D, out, norm_pre + 2 * D, XN, nullptr, nullptr, nullptr);
    SEAM(9);
    if (IN(10)) {
        pg8::Gemm g{XN, W2I, M, 2 * FF, D}; pg8::StaticOrder S; S.init(M, 2 * FF, G, bx);
        pg8::EpiSwiglu E{ACT, FF};
        pg8::gemm_phase<pg8::EpiSwiglu, pg8::StaticOrder, PG8_ALIGN, PG8_SP2>(ldsl, g, S, E);
    }
    SEAM(10);
    if (IN(11)) {
        pg8::Gemm g{ACT, W2O, M, D, FF}; pg8::StaticOrder S; S.init(M, D, G, bx);
        pg8::EpiF32Part E{Y, D, PART};
        pg8::gemm_phase<pg8::EpiF32Part, pg8::StaticOrder, PG8_ALIGN, PG8_SP2>(ldsl, g, S, E);
    }
    SEAM(11);
    if (IN(12)) norm_rows(gw, NGW, lane, out, Y, PART, 0.5f, norm_post + 2 * D, out, nullptr, nullptr, nullptr, nullptr, nullptr);
#undef IN
#undef SEAM
}

extern "C" void kernel_launch(void* const* d_in, const int* in_sizes, int n_in, void* d_out, int out_size, void* d_ws, size_t ws_size, hipStream_t stream) {
    static int grid = 0;
    if (grid == 0) {
        if (n_in != 15 || out_size != M * D || ws_size < WS_END) { fprintf(stderr, "kernel_launch: unexpected shapes (n_in %d, out %d, ws %zu); nothing launched\n", n_in, out_size, ws_size); grid = -1; return; }
        int dev = 0, cus = 0, per_cu = 0;
        (void)hipGetDevice(&dev); (void)hipDeviceGetAttribute(&cus, hipDeviceAttributeMultiprocessorCount, dev);
        if (hipFuncSetAttribute((const void*)fwd, hipFuncAttributeMaxDynamicSharedMemorySize, LDS_BYTES) != hipSuccess) { fprintf(stderr, "kernel_launch: hipFuncSetAttribute failed\n"); grid = -1; return; }
        if (hipOccupancyMaxActiveBlocksPerMultiprocessor(&per_cu, (const void*)fwd, NTHR, LDS_BYTES) != hipSuccess || per_cu < 1) { fprintf(stderr, "kernel_launch: occupancy query says %d\n", per_cu); per_cu = 1; }
        (void)hipGetLastError();
        grid = cus * per_cu;
    }
    if (grid < 0) return;
    Args a{};
    for (int i = 0; i < 15; ++i) a.in[i] = (const float*)d_in[i];
    a.out = (float*)d_out; a.ws = (unsigned char*)d_ws;
#if MK_COOP
    a.ph_lo = 0; a.ph_hi = NPHASE;
    void* kargs[] = {&a};
    hipError_t e = hipLaunchCooperativeKernel((const void*)fwd, dim3(grid), dim3(NTHR), kargs, LDS_BYTES, stream);
    if (e != hipSuccess) fprintf(stderr, "cooperative launch failed: %s (grid %d)\n", hipGetErrorString(e), grid);
#else
    for (int k = 0; k < NPHASE; ++k) {
        if (MK_RECURRENT && (k == 6 || k == 7)) continue;
        a.ph_lo = k; a.ph_hi = k + 1;
        hipLaunchKernelGGL(fwd, dim3(grid), dim3(NTHR), LDS_BYTES, stream, a);
    }
#endif
}
```
